# Optimizing an MI355X kernel written in HIP

```python
import jax
import jax.numpy as jnp
from jax import lax
import numpy as np

D_MODEL = 2048
BATCH = 1
SEQ = 8192
DEPTH = 1

HEAD_DIM = 64
D_MIX = D_MODEL
RWKV_WIDTH = D_MIX // 2
RWKV_HEADS = RWKV_WIDTH // HEAD_DIM
ATTN_WIDTH = D_MIX - RWKV_WIDTH
ATTN_Q_HEADS = ATTN_WIDTH // HEAD_DIM
ATTN_KV_HEADS = 4
ATTN_GROUP = ATTN_Q_HEADS // ATTN_KV_HEADS
ATTN_KV_WIDTH = ATTN_KV_HEADS * HEAD_DIM
WINDOW = 128
ROPE_THETA = 10000.0
DECAY_LORA = 64
AAA_LORA = 64
GATE_LORA = 160
RWKV_COLS = 3 * RWKV_WIDTH + DECAY_LORA + AAA_LORA + GATE_LORA
ATTN_COLS = ATTN_WIDTH + 2 * ATTN_KV_WIDTH
N_IN_COLS = RWKV_COLS + ATTN_COLS
N_GROUPS = 8
EXPERTS_PER_GROUP = 8
N_EXPERTS = N_GROUPS * EXPERTS_PER_GROUP
TOP_K_INNER = 2
D_EXPERT = 768
MOE_BLOCK = 256
RMS_EPS = 1e-6
RWKV_GN_EPS = 64e-5

kernel_name = "hymba_rwkv7_swa_sink_hier_moe"


def rms_norm(x, gain):
    xf = x.astype(jnp.float32)
    y = xf * lax.rsqrt(jnp.mean(xf * xf, axis=-1, keepdims=True) + RMS_EPS)
    return (y * gain.astype(jnp.float32)).astype(x.dtype)


def token_shift(p):
    return jnp.concatenate([jnp.zeros_like(p[:, :1]), p[:, :-1]], axis=1)


def apply_rope(x, positions):
    inv_freq = ROPE_THETA ** (-jnp.arange(0, HEAD_DIM, 2, dtype=jnp.float32) / HEAD_DIM)
    ang = positions.astype(jnp.float32)[:, :, None, None] * inv_freq
    cos, sin = jnp.cos(ang), jnp.sin(ang)
    xf = x.astype(jnp.float32)
    x1, x2 = xf[..., : HEAD_DIM // 2], xf[..., HEAD_DIM // 2:]
    return jnp.concatenate([x1 * cos - x2 * sin, x2 * cos + x1 * sin], axis=-1).astype(x.dtype)


def _rwkv7_step(state, inp):
    r, w, k, v, a_, b_ = inp
    sa = jnp.einsum("bhvk,bhk->bhv", state, a_)
    state = state * w[..., None, :] + sa[..., :, None] * b_[..., None, :] + v[..., :, None] * k[..., None, :]
    y = jnp.einsum("bhvk,bhk->bhv", state, r)
    return state, y


def rwkv7_time_mix(p, mu, w_decay0, w_decay_up, a0, w_a_up, w_g_up, k_k, k_a, r_k, gn_w, gn_b):
    B, T, _ = p.shape
    H, N = RWKV_HEADS, HEAD_DIM
    f32 = jnp.float32
    ps = p + (token_shift(p) - p) * mu
    o1, o2, o3 = RWKV_WIDTH, 2 * RWKV_WIDTH, 3 * RWKV_WIDTH
    o4, o5 = o3 + DECAY_LORA, o3 + DECAY_LORA + AAA_LORA
    r, k, v = ps[..., :o1], ps[..., o1:o2], ps[..., o2:o3]
    wd, ad, gd = ps[..., o3:o4], ps[..., o4:o5], ps[..., o5:]
    w_log = -jax.nn.softplus(-(w_decay0 + jnp.tanh(wd) @ w_decay_up)) - 0.5
    decay = jnp.exp(-jnp.exp(w_log.astype(f32)))
    a = jax.nn.sigmoid(a0 + ad @ w_a_up)
    g = jax.nn.sigmoid(gd) @ w_g_up

    def heads(t):
        return t.astype(f32).reshape(B, T, H, N)

    r, k, v, a, decay = heads(r), heads(k), heads(v), heads(a), heads(decay)
    kk = k * k_k.astype(f32).reshape(H, N)
    kk = kk / jnp.maximum(jnp.sqrt(jnp.sum(kk * kk, axis=-1, keepdims=True)), 1e-12)
    k = k * (1.0 + (a - 1.0) * k_a.astype(f32).reshape(H, N))
    xs = tuple(jnp.moveaxis(t, 1, 0) for t in (r, decay, k, v, -kk, kk * a))
    s0 = jnp.zeros((B, H, N, N), f32)
    _, y = lax.scan(_rwkv7_step, s0, xs)
    y = jnp.moveaxis(y, 0, 1)
    mean = jnp.mean(y, axis=-1, keepdims=True)
    var = jnp.mean(jnp.square(y - mean), axis=-1, keepdims=True)
    y = (y - mean) * lax.rsqrt(var + RWKV_GN_EPS)
    y = y * gn_w.astype(f32).reshape(H, N) + gn_b.astype(f32).reshape(H, N)
    y = y + jnp.sum(r * k * r_k.astype(f32), axis=-1, keepdims=True) * v
    return (y.reshape(B, T, RWKV_WIDTH) * g.astype(f32)).astype(p.dtype)


def swa_sink_attention(q, k, v, positions, sinks):
    B, T = q.shape[0], q.shape[1]
    nb = T // WINDOW
    scale = HEAD_DIM ** -0.5
    q = apply_rope(q, positions) * scale
    k = apply_rope(k, positions)
    qb = q.reshape(B, nb, WINDOW, ATTN_KV_HEADS, ATTN_GROUP, HEAD_DIM)
    kb = k.reshape(B, nb, WINDOW, ATTN_KV_HEADS, HEAD_DIM)
    vb = v.reshape(B, nb, WINDOW, ATTN_KV_HEADS, HEAD_DIM)

    def band(t):
        prev = jnp.concatenate([jnp.zeros_like(t[:, :1]), t[:, :-1]], axis=1)
        return jnp.concatenate([prev, t], axis=2)

    k_band, v_band = band(kb), band(vb)
    s = jnp.einsum("bnqhgd,bnkhd->bnhgqk", qb, k_band).astype(jnp.float32)
    qi = jnp.arange(WINDOW) + WINDOW
    ki = jnp.arange(2 * WINDOW)
    rel = qi[:, None] - ki[None, :]
    local = (rel >= 0) & (rel < WINDOW)
    first_ok = (jnp.arange(nb)[:, None, None] > 0) | (ki[None, None, :] >= WINDOW)
    mask = local[None] & first_ok
    s = jnp.where(mask[None, :, None, None], s, -jnp.inf)
    sink = sinks.astype(jnp.float32).reshape(ATTN_KV_HEADS, ATTN_GROUP)[None, None, :, :, None, None]
    m = jnp.maximum(jnp.max(s, axis=-1, keepdims=True), sink)
    pexp = jnp.exp(s - m)
    denom = jnp.sum(pexp, axis=-1, keepdims=True) + jnp.exp(sink - m)
    probs = (pexp / denom).astype(v.dtype)
    o = jnp.einsum("bnhgqk,bnkhd->bnqhgd", probs, v_band)
    return o.reshape(B, T, ATTN_WIDTH)


def hierarchical_moe(x, w_rg, b_rg, w_re, b_re, w_gu, w_dn):
    B, T, D = x.shape
    xt = x.reshape(-1, D)
    n = xt.shape[0]
    m_assign = n * TOP_K_INNER
    p_group = jax.nn.softmax((xt @ w_rg + b_rg).astype(jnp.float32), axis=-1)
    pg_top, g_idx = lax.top_k(p_group, 1)
    el = (xt @ w_re + b_re).astype(jnp.float32).reshape(n, N_GROUPS, EXPERTS_PER_GROUP)
    el_sel = el[jnp.arange(n), g_idx[:, 0]]
    top_vals, e_loc = lax.top_k(el_sel, TOP_K_INNER)
    gate = pg_top * jax.nn.softmax(top_vals, axis=-1)
    eid = (g_idx * EXPERTS_PER_GROUP + e_loc).reshape(-1).astype(jnp.int32)
    tok = jnp.repeat(jnp.arange(n, dtype=jnp.int32), TOP_K_INNER)
    gate_flat = gate.reshape(-1)
    order = jnp.argsort(eid)
    eid_s, tok_s, gate_s = eid[order], tok[order], gate_flat[order]
    counts = jnp.bincount(eid, length=N_EXPERTS).astype(jnp.int32)
    padded = ((counts + MOE_BLOCK - 1) // MOE_BLOCK) * MOE_BLOCK
    pad_end = jnp.cumsum(padded)
    pad_start = pad_end - padded
    start = jnp.cumsum(counts) - counts
    dest = pad_start[eid_s] + (jnp.arange(m_assign, dtype=jnp.int32) - start[eid_s])
    n_blocks = -(-m_assign // MOE_BLOCK) + N_EXPERTS
    cap = n_blocks * MOE_BLOCK
    tok_pad = jnp.full((cap,), n, dtype=jnp.int32).at[dest].set(tok_s)
    gate_pad = jnp.zeros((cap,), x.dtype).at[dest].set(gate_s.astype(x.dtype))
    blk_start = jnp.arange(n_blocks, dtype=jnp.int32) * MOE_BLOCK
    blk_exp = jnp.minimum(jnp.searchsorted(pad_end, blk_start, side="right"), N_EXPERTS - 1)
    x_pad = jnp.concatenate([xt, jnp.zeros((1, D), xt.dtype)], axis=0)
    xb = x_pad[tok_pad].reshape(n_blocks, MOE_BLOCK, D)

    def expert_block(args):
        xblk, e = args
        hgu = xblk @ w_gu[e]
        hg, hu = hgu[:, :D_EXPERT], hgu[:, D_EXPERT:]
        return (jax.nn.silu(hg) * hu) @ w_dn[e]

    yb = lax.map(expert_block, (xb, blk_exp)).reshape(cap, D)
    y = jax.ops.segment_sum(yb * gate_pad[:, None], tok_pad, num_segments=n + 1)[:n]
    return y.reshape(B, T, D)


def setup_inputs(seed: int = 0) -> dict:
    key = jax.random.key(seed)
    ks = jax.random.split(key, 24)
    f32 = jnp.float32

    def nrm(k, shape, scale):
        return jax.random.normal(k, shape, f32) * scale

    return {
        "x": nrm(ks[0], (BATCH, SEQ, D_MODEL), 1.0),
        "positions": jnp.tile(jnp.arange(SEQ, dtype=jnp.int32)[None, :], (BATCH, 1)),
        "ln1": 1.0 + nrm(ks[1], (DEPTH, D_MODEL), 0.01),
        "w_in": nrm(ks[2], (DEPTH, D_MODEL, N_IN_COLS), D_MODEL ** -0.5),
        "mu_shift": jax.random.uniform(ks[3], (DEPTH, RWKV_COLS), f32),
        "w_decay0": jax.random.uniform(ks[4], (DEPTH, RWKV_WIDTH), f32, -6.0, 1.0),
        "w_decay_up": nrm(ks[5], (DEPTH, DECAY_LORA, RWKV_WIDTH), 0.1),
        "a0": nrm(ks[6], (DEPTH, RWKV_WIDTH), 0.5),
        "w_a_up": nrm(ks[7], (DEPTH, AAA_LORA, RWKV_WIDTH), 0.1),
        "w_g_up": nrm(ks[8], (DEPTH, GATE_LORA, RWKV_WIDTH), GATE_LORA ** -0.5),
        "k_k": 0.85 + nrm(ks[9], (DEPTH, RWKV_WIDTH), 0.05),
        "k_a": 1.0 + nrm(ks[10], (DEPTH, RWKV_WIDTH), 0.05),
        "r_k": nrm(ks[11], (DEPTH, RWKV_HEADS, HEAD_DIM), 0.1),
        "gn_w": 1.0 + nrm(ks[12], (DEPTH, RWKV_WIDTH), 0.05),
        "gn_b": nrm(ks[13], (DEPTH, RWKV_WIDTH), 0.02),
        "sinks": nrm(ks[14], (DEPTH, ATTN_Q_HEADS), 1.0),
        "w_out": nrm(ks[15], (DEPTH, D_MIX, D_MODEL), D_MIX ** -0.5),
        "ln2": 1.0 + nrm(ks[16], (DEPTH, D_MODEL), 0.01),
        "w_router_group": nrm(ks[17], (DEPTH, D_MODEL, N_GROUPS), D_MODEL ** -0.5),
        "b_router_group": nrm(ks[18], (DEPTH, N_GROUPS), 0.01),
        "w_router_expert": nrm(ks[19], (DEPTH, D_MODEL, N_EXPERTS), D_MODEL ** -0.5),
        "b_router_expert": nrm(ks[20], (DEPTH, N_EXPERTS), 0.01),
        "w_expert_gu": nrm(ks[21], (DEPTH, N_EXPERTS, D_MODEL, 2 * D_EXPERT), D_MODEL ** -0.5),
        "w_expert_down": nrm(ks[22], (DEPTH, N_EXPERTS, D_EXPERT, D_MODEL), D_EXPERT ** -0.5),
        "ln_f": 1.0 + nrm(ks[23], (D_MODEL,), 0.01),
    }


def reference(x, positions, ln1, w_in, mu_shift, w_decay0, w_decay_up, a0, w_a_up, w_g_up,
              k_k, k_a, r_k, gn_w, gn_b, sinks, w_out, ln2, w_router_group, b_router_group,
              w_router_expert, b_router_expert, w_expert_gu, w_expert_down, ln_f):
    B, T, _ = x.shape
    for l in range(DEPTH):
        h = rms_norm(x, ln1[l])
        p = h @ w_in[l]
        p_rwkv = p[..., :RWKV_COLS]
        p_attn = p[..., RWKV_COLS:]
        y_rwkv = rwkv7_time_mix(p_rwkv, mu_shift[l], w_decay0[l], w_decay_up[l], a0[l], w_a_up[l],
                                w_g_up[l], k_k[l], k_a[l], r_k[l], gn_w[l], gn_b[l])
        q = p_attn[..., :ATTN_WIDTH].reshape(B, T, ATTN_Q_HEADS, HEAD_DIM)
        kv = p_attn[..., ATTN_WIDTH:]
        k = kv[..., :ATTN_KV_WIDTH].reshape(B, T, ATTN_KV_HEADS, HEAD_DIM)
        v = kv[..., ATTN_KV_WIDTH:].reshape(B, T, ATTN_KV_HEADS, HEAD_DIM)
        y_attn = swa_sink_attention(q, k, v, positions, sinks[l])
        x = x + jnp.concatenate([y_rwkv, y_attn], axis=-1) @ w_out[l]
        h = rms_norm(x, ln2[l])
        x = x + hierarchical_moe(h, w_router_group[l], b_router_group[l], w_router_expert[l],
                                 b_router_expert[l], w_expert_gu[l], w_expert_down[l])
    return rms_norm(x, ln_f)
```

```cpp
#include <hip/hip_runtime.h>
#include <stdint.h>

typedef _Float16 f16;
typedef _Float16 half8 __attribute__((ext_vector_type(8)));
typedef _Float16 half4 __attribute__((ext_vector_type(4)));
typedef _Float16 half2v __attribute__((ext_vector_type(2)));
typedef float f32x16 __attribute__((ext_vector_type(16)));
typedef float f32x4 __attribute__((ext_vector_type(4)));
typedef unsigned u32x4 __attribute__((ext_vector_type(4)));
typedef const __attribute__((address_space(4))) float* cfp;

#define T_ 8192
#define D_ 2048
#define NIN 4896
#define NINP 5120
#define RW 1024
#define NH 16
#define C_R 0
#define C_K 1024
#define C_V 2048
#define C_WD 3072
#define C_AD 3136
#define C_GD 3200
#define C_AQ 3360
#define C_AK 4384
#define C_AV 4640
#define NSEG 64
#define SEGL 128
#define DE 768
#define NEXP 64
#define NTHR 512
#define LDS_BYTES (128 * 1024)

struct Params {
    const float* x; const int* pos; const float* ln1; const float* w_in; const float* mu; const float* w_decay0; const float* w_decay_up;
    const float* a0; const float* w_a_up; const float* w_g_up; const float* k_k; const float* k_a; const float* r_k; const float* gn_w; const float* gn_b;
    const float* sinks; const float* w_out; const float* ln2; const float* w_rg; const float* b_rg; const float* w_re; const float* b_re;
    const float* w_gu; const float* w_dn; const float* ln_f;
    float* out;
    unsigned* bar;
    f16* xh; float* rstd1; f16* WinT; f16* WoutT; f16* WduT; f16* WauT; f16* WguT; float* ropec; float* ropes;
    f16* P; f16* td; f16* ad; f16* sg; f16* qr; f16* kr;
    float* Wd; float* Aa; f16* G; float* R; float* K2; float* V; float* A; float* B; float* bonus;
    float* segP; float* segQ; float* Sst; float* yraw; f16* ycat; float* x1; f16* xm; float* rstd2;
    int* eid; float* gate; int* cnt; int* list; f16* Hbuf; float* Y2;
};


#define XB_TMO      128
#define XB_XCNT(j)  (256  + 64 * (j))
#define XB_XSUB(j)  (1280 + 64 * (j))
#define XB_XGEN(j)  (2304 + 64 * (j))
#define XB_TOP      3328
#define XB_TOPGEN   3392
#define XCD_BAR_WORDS 3456
#define XB_SPIN_CAP (1u << 18)
#define LAS __attribute__((address_space(3)))

__device__ __forceinline__ unsigned xb_ld(unsigned* p)              { return __hip_atomic_load(p, __ATOMIC_RELAXED, __HIP_MEMORY_SCOPE_AGENT); }
__device__ __forceinline__ unsigned xb_add(unsigned* p, unsigned v) { return __hip_atomic_fetch_add(p, v, __ATOMIC_RELAXED, __HIP_MEMORY_SCOPE_AGENT); }
__device__ __forceinline__ unsigned xb_xcc_id() { return (unsigned)__builtin_amdgcn_s_getreg((3 << 11) | 20) & 0xFu; }
#define XB_SPIN(cond, bar) do { unsigned _sp = 0; while (cond) { __builtin_amdgcn_s_sleep(1); \
    if ((++_sp & 255u) == 0u) { if (xb_ld(&(bar)[XB_TMO])) break; if (_sp > XB_SPIN_CAP) { atomicAdd(&(bar)[XB_TMO], 1u); break; } } } } while (0)

struct XcdBarrier { unsigned* bar; unsigned x; volatile LAS unsigned* st; };

__device__ __forceinline__ XcdBarrier xcd_barrier_post(unsigned* bar, volatile LAS unsigned* st) {
    XcdBarrier b; b.bar = bar; b.x = xb_xcc_id(); b.st = st;
    if (threadIdx.x == 0) (void)xb_add(&bar[XB_XCNT(b.x)], 1u);
    return b;
}
__device__ __forceinline__ void xcd_barrier_complete(unsigned* bar, unsigned x, unsigned& nloc, unsigned& nx) {
    const unsigned G = gridDim.x * gridDim.y * gridDim.z;
    unsigned sum, cnt, mine, sp = 0u;
    for (;;) {
        sum = 0u; cnt = 0u; mine = 0u;
#pragma unroll
        for (unsigned j = 0; j < 16; ++j) { const unsigned c = xb_ld(&bar[XB_XCNT(j)]); sum += c; cnt += (c > 0u) ? 1u : 0u; mine = (j == x) ? c : mine; }
        if (sum == G) break;
        __builtin_amdgcn_s_sleep(1);
        if ((++sp & 255u) == 0u) { if (xb_ld(&bar[XB_TMO])) break; if (sp > XB_SPIN_CAP) { atomicAdd(&bar[XB_TMO], 1u); break; } }
    }
    nloc = mine > 0u ? mine : 1u; nx = cnt > 0u ? cnt : 1u;
}
__device__ __forceinline__ void xcd_barrier(const XcdBarrier& b) {
    asm volatile("s_waitcnt vmcnt(0)" ::: "memory");
    __syncthreads();
    if (threadIdx.x == 0) {
        unsigned* bar = b.bar;
        __builtin_amdgcn_s_waitcnt(0);
        unsigned nloc = b.st[0], nx = b.st[1];
        if (nloc == 0u) { xcd_barrier_complete(bar, b.x, nloc, nx); b.st[0] = nloc; b.st[1] = nx; }
        const unsigned old = xb_add(&bar[XB_XSUB(b.x)], 1u);
        const unsigned gen = old / nloc;
        if (old + 1u == (gen + 1u) * nloc) {
            __builtin_amdgcn_fence(__ATOMIC_RELEASE, "agent");
            asm volatile("s_waitcnt vmcnt(0)" ::: "memory");
            const unsigned og = xb_add(&bar[XB_TOP], 1u);
            const unsigned tg = og / nx;
            if (og + 1u == (tg + 1u) * nx) xb_add(&bar[XB_TOPGEN], 1u);
            else XB_SPIN(xb_ld(&bar[XB_TOPGEN]) == tg, bar);
            __builtin_amdgcn_fence(__ATOMIC_ACQUIRE, "agent");
            xb_add(&bar[XB_XGEN(b.x)], 1u);
            asm volatile("s_waitcnt vmcnt(0)" ::: "memory");
        } else {
            XB_SPIN(xb_ld(&bar[XB_XGEN(b.x)]) == gen, bar);
            __builtin_amdgcn_fence(__ATOMIC_ACQUIRE, "agent");
            asm volatile("s_waitcnt vmcnt(0)" ::: "memory");
        }
    }
    __syncthreads();
}

__device__ __forceinline__ float wave_sum(float v) {
#pragma unroll
    for (int o = 32; o > 0; o >>= 1) v += __shfl_xor(v, o);
    return v;
}

__device__ __forceinline__ void transpose_cvt(char* smem, const float* src, int K, int N, int Npad, f16* dst, int bid, int nb) {
    float* t = (float*)smem;
    const int tid = threadIdx.x;
    const int ktiles = (K + 63) / 64, ntiles = Npad / 64;
    for (int tile = bid; tile < ktiles * ntiles; tile += nb) {
        const int kb = tile % ktiles, nbk = tile / ktiles;
        __syncthreads();
        {
            const int n_l = tid & 63, k_l0 = tid >> 6;
#pragma unroll
            for (int i = 0; i < 8; ++i) {
                const int k_l = k_l0 + 8 * i, k = kb * 64 + k_l, n = nbk * 64 + n_l;
                float v = 0.f;
                if (k < K && n < N) v = src[(size_t)k * N + n];
                t[k_l * 65 + n_l] = v;
            }
        }
        __syncthreads();
        {
            const int k_l = tid & 63, n_l0 = tid >> 6;
#pragma unroll
            for (int i = 0; i < 8; ++i) {
                const int n_l = n_l0 + 8 * i, k = kb * 64 + k_l, n = nbk * 64 + n_l;
                if (k < K) dst[(size_t)n * K + k] = (f16)t[k_l * 65 + n_l];
            }
        }
    }
}

__device__ __forceinline__ void phase_prologue(const Params& p, char* smem) {
    const int tid = threadIdx.x, lane = tid & 63, wid = tid >> 6, bid = blockIdx.x, nb = gridDim.x;
    for (int row = bid * 8 + wid; row < T_; row += nb * 8) {
        const float* xr = p.x + (size_t)row * D_;
        float ss = 0.f;
#pragma unroll
        for (int i = 0; i < 8; ++i) {
            const int c = lane * 4 + i * 256;
            const f32x4 v = *(const f32x4*)(xr + c);
            const f32x4 g = *(const f32x4*)(p.ln1 + c);
            ss += v[0] * v[0] + v[1] * v[1] + v[2] * v[2] + v[3] * v[3];
            half4 hv; hv[0] = (f16)(v[0] * g[0]); hv[1] = (f16)(v[1] * g[1]); hv[2] = (f16)(v[2] * g[2]); hv[3] = (f16)(v[3] * g[3]);
            *(half4*)(p.xh + (size_t)row * D_ + c) = hv;
        }
        ss = wave_sum(ss);
        if (lane == 0) p.rstd1[row] = 1.0f / sqrtf(ss * (1.0f / D_) + 1e-6f);
    }
    transpose_cvt(smem, p.w_in, D_, NIN, NINP, p.WinT, bid, nb);
    transpose_cvt(smem, p.w_out, D_, D_, D_, p.WoutT, bid, nb);
    transpose_cvt(smem, p.w_decay_up, 64, RW, RW, p.WduT, bid, nb);
    transpose_cvt(smem, p.w_a_up, 64, RW, RW, p.WauT, bid, nb);
    transpose_cvt(smem, p.w_g_up, 160, RW, RW, p.WguT, bid, nb);
    for (int idx = bid * NTHR + tid; idx < T_ * 32; idx += nb * NTHR) {
        const int t = idx >> 5, i = idx & 31;
        const double inv = pow(10000.0, -(double)i / 32.0);
        const double ang = (double)p.pos[t] * inv;
        p.ropec[idx] = (float)cos(ang); p.ropes[idx] = (float)sin(ang);
    }
}

template <int BK> struct GemmCfg { static constexpr int STRIDE = BK * 2 + 16; static constexpr int NCH = BK / 32; static constexpr int B_OFF = 128 * STRIDE; };

template <int BK, bool BF32, class Epi>
__device__ __forceinline__ void gemm_tile(char* smem, int K, const f16* const (&aptr)[GemmCfg<BK>::NCH], const f16* const (&bptr)[GemmCfg<BK>::NCH],
                                          const float* wB, int ldw, const Epi& epi) {
    constexpr int STRIDE = GemmCfg<BK>::STRIDE, NCH = GemmCfg<BK>::NCH, B_OFF = GemmCfg<BK>::B_OFF;
    const int tid = threadIdx.x, lane = tid & 63, wid = tid >> 6, wm = wid >> 1, wn = wid & 1, r = lane & 31, h = lane >> 5;
    char* As = smem; char* Bs = smem + B_OFF;
    f32x16 acc0, acc1;
#pragma unroll
    for (int i = 0; i < 16; ++i) { acc0[i] = 0.f; acc1[i] = 0.f; }
    u32x4 ra[NCH], rb[NCH]; f32x4 rw[4];
    int aoff[NCH];
#pragma unroll
    for (int i = 0; i < NCH; ++i) { const int c = tid + NTHR * i; aoff[i] = (c / (BK / 8)) * STRIDE + (c % (BK / 8)) * 16; }
    const int nk = K / BK;
#pragma unroll
    for (int i = 0; i < NCH; ++i) ra[i] = *(const u32x4*)(aptr[i]);
    if constexpr (BF32) {
#pragma unroll
        for (int j = 0; j < 4; ++j) rw[j] = *(const f32x4*)(wB + (size_t)(4 * (tid >> 5) + j) * ldw);
    } else {
#pragma unroll
        for (int i = 0; i < NCH; ++i) rb[i] = *(const u32x4*)(bptr[i]);
    }
    for (int kt = 0; kt < nk; ++kt) {
        __syncthreads();
#pragma unroll
        for (int i = 0; i < NCH; ++i) *(u32x4*)(As + aoff[i]) = ra[i];
        if constexpr (BF32) {
            const int ng = tid & 31, kg = tid >> 5;
#pragma unroll
            for (int ni = 0; ni < 4; ++ni) {
                half4 hv; hv[0] = (f16)rw[0][ni]; hv[1] = (f16)rw[1][ni]; hv[2] = (f16)rw[2][ni]; hv[3] = (f16)rw[3][ni];
                *(half4*)(Bs + (4 * ng + ni) * STRIDE + kg * 8) = hv;
            }
        } else {
#pragma unroll
            for (int i = 0; i < NCH; ++i) *(u32x4*)(Bs + aoff[i]) = rb[i];
        }
        __syncthreads();
        if (kt + 1 < nk) {
            const int k0 = (kt + 1) * BK;
#pragma unroll
            for (int i = 0; i < NCH; ++i) ra[i] = *(const u32x4*)(aptr[i] + k0);
            if constexpr (BF32) {
#pragma unroll
                for (int j = 0; j < 4; ++j) rw[j] = *(const f32x4*)(wB + (size_t)(k0 + 4 * (tid >> 5) + j) * ldw);
            } else {
#pragma unroll
                for (int i = 0; i < NCH; ++i) rb[i] = *(const u32x4*)(bptr[i] + k0);
            }
        }
#pragma unroll
        for (int s = 0; s < BK / 16; ++s) {
            const half8 a = *(const half8*)(As + (32 * wm + r) * STRIDE + (16 * s + 8 * h) * 2);
            const half8 b0 = *(const half8*)(Bs + (64 * wn + r) * STRIDE + (16 * s + 8 * h) * 2);
            const half8 b1 = *(const half8*)(Bs + (64 * wn + 32 + r) * STRIDE + (16 * s + 8 * h) * 2);
            acc0 = __builtin_amdgcn_mfma_f32_32x32x16_f16(b0, a, acc0, 0, 0, 0);
            acc1 = __builtin_amdgcn_mfma_f32_32x32x16_f16(b1, a, acc1, 0, 0, 0);
        }
    }
    epi(32 * wm + r, 64 * wn + 4 * h, acc0, acc1);
}

template <int BK> __device__ __forceinline__ int ch_row(int i) { return (threadIdx.x + NTHR * i) / (BK / 8); }
template <int BK> __device__ __forceinline__ int ch_col(int i) { return ((threadIdx.x + NTHR * i) % (BK / 8)) * 8; }

__device__ __forceinline__ void phase_inproj(const Params& p, char* smem) {
    const int ntn = NINP / 128, ntm = T_ / 128;
    for (int u = blockIdx.x; u < ntm * ntn; u += gridDim.x) {
        const int tm = u / ntn, tn = u % ntn;
        const f16* ap[2]; const f16* bp[2];
#pragma unroll
        for (int i = 0; i < 2; ++i) {
            ap[i] = p.xh + (size_t)(tm * 128 + ch_row<64>(i)) * D_ + ch_col<64>(i);
            bp[i] = p.WinT + (size_t)(tn * 128 + ch_row<64>(i)) * D_ + ch_col<64>(i);
        }
        f16* Pp = p.P; const float* rs = p.rstd1;
        gemm_tile<64, false>(smem, D_, ap, bp, nullptr, 0, [=](int ml, int nl, const f32x16& a0, const f32x16& a1) {
            const int m = tm * 128 + ml; const float sc = rs[m];
            auto st = [&](const f32x16& a, int j) {
#pragma unroll
                for (int g = 0; g < 4; ++g) {
                    const int n = tn * 128 + nl + 32 * j + 8 * g;
                    half4 hv; hv[0] = (f16)(a[4 * g] * sc); hv[1] = (f16)(a[4 * g + 1] * sc); hv[2] = (f16)(a[4 * g + 2] * sc); hv[3] = (f16)(a[4 * g + 3] * sc);
                    *(half4*)(Pp + (size_t)m * NINP + n) = hv;
                }
            };
            st(a0, 0); st(a1, 1);
        });
    }
}

__device__ __forceinline__ float ps_val(const f16* P, const float* mu, int t, int c) {
    const float cur = (float)P[(size_t)t * NINP + c];
    const float prv = t > 0 ? (float)P[(size_t)(t - 1) * NINP + c] : 0.f;
    return cur + (prv - cur) * mu[c];
}
__device__ __forceinline__ void phase_prepA(const Params& p, char* smem) {
    const int tid = threadIdx.x, lane = tid & 63, wid = tid >> 6;
    for (int t = blockIdx.x * 8 + wid; t < T_; t += gridDim.x * 8) {
        for (int c = lane; c < 288; c += 64) {
            const float v = ps_val(p.P, p.mu, t, C_WD + c);
            if (c < 64) p.td[(size_t)t * 64 + c] = (f16)tanhf(v);
            else if (c < 128) p.ad[(size_t)t * 64 + (c - 64)] = (f16)v;
            else p.sg[(size_t)t * 160 + (c - 128)] = (f16)(1.0f / (1.0f + expf(-v)));
        }
        for (int i = lane; i < 640; i += 64) {
            const int hd = i >> 5, j = i & 31;
            const float cs = p.ropec[t * 32 + j], sn = p.ropes[t * 32 + j];
            if (hd < 16) {
                const float x1 = (float)p.P[(size_t)t * NINP + C_AQ + hd * 64 + j], x2 = (float)p.P[(size_t)t * NINP + C_AQ + hd * 64 + 32 + j];
                p.qr[(size_t)t * 1024 + hd * 64 + j] = (f16)((x1 * cs - x2 * sn) * 0.125f);
                p.qr[(size_t)t * 1024 + hd * 64 + 32 + j] = (f16)((x2 * cs + x1 * sn) * 0.125f);
            } else {
                const int kh = hd - 16;
                const float x1 = (float)p.P[(size_t)t * NINP + C_AK + kh * 64 + j], x2 = (float)p.P[(size_t)t * NINP + C_AK + kh * 64 + 32 + j];
                p.kr[(size_t)t * 256 + kh * 64 + j] = (f16)(x1 * cs - x2 * sn);
                p.kr[(size_t)t * 256 + kh * 64 + 32 + j] = (f16)(x2 * cs + x1 * sn);
            }
        }
    }
}

__device__ __forceinline__ void phase_lora(const Params& p, char* smem) {
    const int ntn = RW / 128, ntm = T_ / 128, per = ntm * ntn;
    for (int u = blockIdx.x; u < 3 * per; u += gridDim.x) {
        const int which = u / per, uu = u % per, tm = uu / ntn, tn = uu % ntn;
        const int K = which == 2 ? 160 : 64;
        const f16* Asrc = which == 0 ? p.td : which == 1 ? p.ad : p.sg;
        const f16* Bsrc = which == 0 ? p.WduT : which == 1 ? p.WauT : p.WguT;
        const f16* ap[1]; const f16* bp[1];
        ap[0] = Asrc + (size_t)(tm * 128 + ch_row<32>(0)) * K + ch_col<32>(0);
        bp[0] = Bsrc + (size_t)(tn * 128 + ch_row<32>(0)) * K + ch_col<32>(0);
        float* Wd = p.Wd; float* Aa = p.Aa; f16* G = p.G; const float* wd0 = p.w_decay0; const float* a0p = p.a0;
        gemm_tile<32, false>(smem, K, ap, bp, nullptr, 0, [=](int ml, int nl, const f32x16& c0, const f32x16& c1) {
            const int m = tm * 128 + ml;
            auto st = [&](const f32x16& a, int j) {
#pragma unroll
                for (int g = 0; g < 4; ++g) {
                    const int n = tn * 128 + nl + 32 * j + 8 * g;
                    if (which == 0) {
                        f32x4 o;
#pragma unroll
                        for (int e = 0; e < 4; ++e) {
                            const float xx = wd0[n + e] + a[4 * g + e];
                            const float wlog = -log1pf(expf(-xx)) - 0.5f;
                            o[e] = expf(-expf(wlog));
                        }
                        *(f32x4*)(Wd + (size_t)m * RW + n) = o;
                    } else if (which == 1) {
                        f32x4 o;
#pragma unroll
                        for (int e = 0; e < 4; ++e) o[e] = 1.0f / (1.0f + expf(-(a0p[n + e] + a[4 * g + e])));
                        *(f32x4*)(Aa + (size_t)m * RW + n) = o;
                    } else {
                        half4 hv; hv[0] = (f16)a[4 * g]; hv[1] = (f16)a[4 * g + 1]; hv[2] = (f16)a[4 * g + 2]; hv[3] = (f16)a[4 * g + 3];
                        *(half4*)(G + (size_t)m * RW + n) = hv;
                    }
                }
            };
            st(c0, 0); st(c1, 1);
        });
    }
}

__device__ __forceinline__ void phase_prepB(const Params& p, char* smem) {
    const int tid = threadIdx.x, lane = tid & 63, wid = tid >> 6;
    for (int t = blockIdx.x * 8 + wid; t < T_; t += gridDim.x * 8) {
        for (int hd = 0; hd < NH; ++hd) {
            const int c = hd * 64 + lane;
            const float r = ps_val(p.P, p.mu, t, C_R + c), k = ps_val(p.P, p.mu, t, C_K + c), v = ps_val(p.P, p.mu, t, C_V + c);
            const float a = p.Aa[(size_t)t * RW + c];
            float kk = k * p.k_k[c];
            const float ss = wave_sum(kk * kk);
            kk = kk / fmaxf(sqrtf(ss), 1e-12f);
            const float k2 = k * (1.0f + (a - 1.0f) * p.k_a[c]);
            const float bs = wave_sum(r * k2 * p.r_k[c]);
            const size_t o = (size_t)t * RW + c;
            p.R[o] = r; p.K2[o] = k2; p.V[o] = v; p.A[o] = -kk; p.B[o] = kk * a;
            if (lane == 0) p.bonus[t * NH + hd] = bs;
        }
    }
}

template <bool HAS_V, bool HAS_Y>
__device__ __forceinline__ void scan_steps(float (&s)[64], const Params& p, int hd, int t0, int nsteps, int lane) {
    unsigned long long bWd = (unsigned long long)p.Wd, bA = (unsigned long long)p.A, bB = (unsigned long long)p.B, bK = (unsigned long long)p.K2, bR = (unsigned long long)p.R;
    asm volatile("" : "+s"(bWd), "+s"(bA), "+s"(bB), "+s"(bK), "+s"(bR) :: "memory");
    for (int t = t0; t < t0 + nsteps; ++t) {
        const size_t o = (size_t)t * RW + hd * 64;
        cfp wp = (cfp)(bWd + o * 4);
        cfp ap = (cfp)(bA + o * 4);
        cfp bp = (cfp)(bB + o * 4);
        float sa = 0.f;
#pragma unroll
        for (int k = 0; k < 64; ++k) sa = fmaf(s[k], ap[k], sa);
        if constexpr (HAS_V) {
            cfp kp = (cfp)(bK + o * 4);
            const float v = p.V[o + lane];
#pragma unroll
            for (int k = 0; k < 64; ++k) s[k] = fmaf(s[k], wp[k], fmaf(sa, bp[k], v * kp[k]));
        } else {
#pragma unroll
            for (int k = 0; k < 64; ++k) s[k] = fmaf(s[k], wp[k], sa * bp[k]);
        }
        if constexpr (HAS_Y) {
            cfp rp = (cfp)(bR + o * 4);
            float y = 0.f;
#pragma unroll
            for (int k = 0; k < 64; ++k) y = fmaf(s[k], rp[k], y);
            p.yraw[o + lane] = y;
        }
    }
}

__device__ __forceinline__ void phase_scan1(const Params& p, char* smem) {
    const int tid = threadIdx.x, lane = tid & 63, wid = __builtin_amdgcn_readfirstlane(tid >> 6);
    for (int u = blockIdx.x; u < NH * NSEG / 4; u += gridDim.x) {
        const int pair = u * 4 + (wid >> 1), type = wid & 1, hd = pair / NSEG, seg = pair % NSEG;
        float s[64];
#pragma unroll
        for (int k = 0; k < 64; ++k) s[k] = (type == 1 && k == lane) ? 1.f : 0.f;
        if (type == 0) scan_steps<true, false>(s, p, hd, seg * SEGL, SEGL, lane);
        else scan_steps<false, false>(s, p, hd, seg * SEGL, SEGL, lane);
        float* dst = (type == 0 ? p.segQ : p.segP) + ((size_t)(hd * NSEG + seg) * 64 + lane) * 64;
#pragma unroll
        for (int k = 0; k < 64; k += 4) { f32x4 v; v[0] = s[k]; v[1] = s[k + 1]; v[2] = s[k + 2]; v[3] = s[k + 3]; *(f32x4*)(dst + k) = v; }
    }
}

__device__ __forceinline__ void phase_scan2(const Params& p, char* smem) {
    float* cur = (float*)smem;
    const int tid = threadIdx.x, row_l = tid >> 6, k = tid & 63;
    for (int u = blockIdx.x; u < NH * 8; u += gridDim.x) {
        const int hd = u >> 3, row = (u & 7) * 8 + row_l;
        float c = 0.f;
        for (int seg = 0; seg < NSEG; ++seg) {
            const size_t base = (size_t)(hd * NSEG + seg) * 4096;
            p.Sst[base + row * 64 + k] = c;
            __syncthreads();
            cur[row_l * 64 + k] = c;
            __syncthreads();
            float acc = p.segQ[base + row * 64 + k];
            const float* Pm = p.segP + base;
#pragma unroll 8
            for (int i = 0; i < 64; ++i) acc = fmaf(cur[row_l * 64 + i], Pm[i * 64 + k], acc);
            c = acc;
        }
        __syncthreads();
    }
}

__device__ __forceinline__ void phase_scan3(const Params& p, char* smem) {
    const int tid = threadIdx.x, lane = tid & 63, wid = __builtin_amdgcn_readfirstlane(tid >> 6);
    for (int u = blockIdx.x; u < NH * NSEG / 8; u += gridDim.x) {
        const int pair = u * 8 + wid, hd = pair / NSEG, seg = pair % NSEG;
        float s[64];
        const float* src = p.Sst + ((size_t)(hd * NSEG + seg) * 64 + lane) * 64;
#pragma unroll
        for (int k = 0; k < 64; k += 4) { const f32x4 v = *(const f32x4*)(src + k); s[k] = v[0]; s[k + 1] = v[1]; s[k + 2] = v[2]; s[k + 3] = v[3]; }
        scan_steps<true, true>(s, p, hd, seg * SEGL, SEGL, lane);
    }
}

__device__ __forceinline__ void phase_rwkvout(const Params& p, char* smem) {
    const int tid = threadIdx.x, lane = tid & 63, wid = tid >> 6;
    for (int t = blockIdx.x * 8 + wid; t < T_; t += gridDim.x * 8) {
        for (int hd = 0; hd < NH; ++hd) {
            const int c = hd * 64 + lane; const size_t o = (size_t)t * RW + c;
            const float y = p.yraw[o];
            const float mean = wave_sum(y) * (1.0f / 64.0f);
            const float d = y - mean;
            const float var = wave_sum(d * d) * (1.0f / 64.0f);
            float yn = d * (1.0f / sqrtf(var + 64e-5f)) * p.gn_w[c] + p.gn_b[c];
            yn += p.bonus[t * NH + hd] * p.V[o];
            p.ycat[(size_t)t * D_ + c] = (f16)(yn * (float)p.G[o]);
        }
    }
}

#define KS_STRIDE 144
#define VT_STRIDE 528
__device__ __forceinline__ void phase_attn(const Params& p, char* smem) {
    const int tid = threadIdx.x, lane = tid & 63, wid = tid >> 6, r = lane & 31, h = lane >> 5;
    char* Ks = smem; char* Vt = smem + 256 * KS_STRIDE;
    for (int u = blockIdx.x; u < 64 * 4; u += gridDim.x) {
        const int qb = u >> 2, kvh = u & 3, t0 = qb * 128;
        __syncthreads();
#pragma unroll
        for (int i = 0; i < 4; ++i) {
            const int c = tid + NTHR * i, key = c >> 3, cc = c & 7, tk = t0 - 128 + key;
            u32x4 kv = {0u, 0u, 0u, 0u}; half8 vv = {0, 0, 0, 0, 0, 0, 0, 0};
            if (tk >= 0) {
                kv = *(const u32x4*)(p.kr + (size_t)tk * 256 + kvh * 64 + cc * 8);
                vv = *(const half8*)(p.P + (size_t)tk * NINP + C_AV + kvh * 64 + cc * 8);
            }
            *(u32x4*)(Ks + key * KS_STRIDE + cc * 16) = kv;
#pragma unroll
            for (int e = 0; e < 8; ++e) *(f16*)(Vt + (cc * 8 + e) * VT_STRIDE + key * 2) = vv[e];
        }
        __syncthreads();
        const int qh = kvh * 4 + (wid >> 1);
        const float sink = p.sinks[qh];
        for (int sub = 0; sub < 2; ++sub) {
            const int q0 = (wid & 1) * 64 + sub * 32;
            half8 qf[4];
#pragma unroll
            for (int s = 0; s < 4; ++s) qf[s] = *(const half8*)(p.qr + (size_t)(t0 + q0 + r) * 1024 + qh * 64 + 16 * s + 8 * h);
            const int qs = q0 >> 5;
            f32x16 sc[5];
#pragma unroll
            for (int mi = 0; mi < 5; ++mi) {
#pragma unroll
                for (int i = 0; i < 16; ++i) sc[mi][i] = 0.f;
#pragma unroll
                for (int s = 0; s < 4; ++s) {
                    const half8 kf = *(const half8*)(Ks + (32 * (qs + mi) + r) * KS_STRIDE + (16 * s + 8 * h) * 2);
                    sc[mi] = __builtin_amdgcn_mfma_f32_32x32x16_f16(kf, qf[s], sc[mi], 0, 0, 0);
                }
            }
            const int qrel = q0 + r;
            float mx = sink;
#pragma unroll
            for (int mi = 0; mi < 5; ++mi)
#pragma unroll
                for (int i = 0; i < 16; ++i) {
                    const int key = 32 * (qs + mi) + (i & 3) + 8 * (i >> 2) + 4 * h;
                    const int rel = qrel + 128 - key;
                    const bool ok = (rel >= 0) && (rel < 128) && (qb > 0 || key >= 128);
                    sc[mi][i] = ok ? sc[mi][i] : -INFINITY;
                    mx = fmaxf(mx, sc[mi][i]);
                }
            mx = fmaxf(mx, __shfl_xor(mx, 32));
            float den = 0.f;
#pragma unroll
            for (int mi = 0; mi < 5; ++mi)
#pragma unroll
                for (int i = 0; i < 16; ++i) { const float e = __expf(sc[mi][i] - mx); sc[mi][i] = e; den += e; }
            den += __shfl_xor(den, 32);
            den += __expf(sink - mx);
            const float inv = 1.0f / den;
            f32x16 o0, o1;
#pragma unroll
            for (int i = 0; i < 16; ++i) { o0[i] = 0.f; o1[i] = 0.f; }
#pragma unroll
            for (int mi = 0; mi < 5; ++mi)
#pragma unroll
                for (int s = 0; s < 2; ++s) {
                    half8 pf;
#pragma unroll
                    for (int j = 0; j < 8; ++j) pf[j] = (f16)(sc[mi][8 * s + j] * inv);
                    const int kb = 32 * (qs + mi) + 16 * s + 4 * h;
                    half8 v0, v1;
                    {
                        const half4 lo = *(const half4*)(Vt + r * VT_STRIDE + kb * 2), hi = *(const half4*)(Vt + r * VT_STRIDE + (kb + 8) * 2);
                        v0[0] = lo[0]; v0[1] = lo[1]; v0[2] = lo[2]; v0[3] = lo[3]; v0[4] = hi[0]; v0[5] = hi[1]; v0[6] = hi[2]; v0[7] = hi[3];
                    }
                    {
                        const half4 lo = *(const half4*)(Vt + (32 + r) * VT_STRIDE + kb * 2), hi = *(const half4*)(Vt + (32 + r) * VT_STRIDE + (kb + 8) * 2);
                        v1[0] = lo[0]; v1[1] = lo[1]; v1[2] = lo[2]; v1[3] = lo[3]; v1[4] = hi[0]; v1[5] = hi[1]; v1[6] = hi[2]; v1[7] = hi[3];
                    }
                    o0 = __builtin_amdgcn_mfma_f32_32x32x16_f16(v0, pf, o0, 0, 0, 0);
                    o1 = __builtin_amdgcn_mfma_f32_32x32x16_f16(v1, pf, o1, 0, 0, 0);
                }
            f16* orow = p.ycat + (size_t)(t0 + q0 + r) * D_ + RW + qh * 64;
#pragma unroll
            for (int g = 0; g < 4; ++g) {
                half4 a, b;
#pragma unroll
                for (int e = 0; e < 4; ++e) { a[e] = (f16)o0[4 * g + e]; b[e] = (f16)o1[4 * g + e]; }
                *(half4*)(orow + 8 * g + 4 * h) = a;
                *(half4*)(orow + 32 + 8 * g + 4 * h) = b;
            }
        }
    }
}

__device__ __forceinline__ void phase_outproj(const Params& p, char* smem) {
    const int ntn = D_ / 128, ntm = T_ / 128;
    for (int u = blockIdx.x; u < ntm * ntn; u += gridDim.x) {
        const int tm = u / ntn, tn = u % ntn;
        const f16* ap[2]; const f16* bp[2];
#pragma unroll
        for (int i = 0; i < 2; ++i) {
            ap[i] = p.ycat + (size_t)(tm * 128 + ch_row<64>(i)) * D_ + ch_col<64>(i);
            bp[i] = p.WoutT + (size_t)(tn * 128 + ch_row<64>(i)) * D_ + ch_col<64>(i);
        }
        const float* xin = p.x; float* x1 = p.x1;
        gemm_tile<64, false>(smem, D_, ap, bp, nullptr, 0, [=](int ml, int nl, const f32x16& a0, const f32x16& a1) {
            const int m = tm * 128 + ml;
            auto st = [&](const f32x16& a, int j) {
#pragma unroll
                for (int g = 0; g < 4; ++g) {
                    const int n = tn * 128 + nl + 32 * j + 8 * g;
                    const f32x4 xv = *(const f32x4*)(xin + (size_t)m * D_ + n);
                    f32x4 o; o[0] = xv[0] + a[4 * g]; o[1] = xv[1] + a[4 * g + 1]; o[2] = xv[2] + a[4 * g + 2]; o[3] = xv[3] + a[4 * g + 3];
                    *(f32x4*)(x1 + (size_t)m * D_ + n) = o;
                }
            };
            st(a0, 0); st(a1, 1);
        });
    }
}

__device__ __forceinline__ float router_w(const Params& p, int k, int c) {
    if (c < 8) return p.w_rg[k * 8 + c];
    if (c < 72) return p.w_re[k * 64 + (c - 8)];
    return 0.f;
}
__device__ __forceinline__ void phase_router(const Params& p, char* smem) {
    const int tid = threadIdx.x, lane = tid & 63, wid = tid >> 6, i32 = lane & 31, kk = lane >> 5;
    float* part = (float*)smem;
    float* ssq = part + 8 * 3 * 16 * 64;
    float* logit = ssq + 8 * 64;
    float* rstd_s = logit + 32 * 72;
    for (int u = blockIdx.x; u < T_ / 32; u += gridDim.x) {
        const int t0 = u * 32;
        f32x16 acc[3];
#pragma unroll
        for (int j = 0; j < 3; ++j)
#pragma unroll
            for (int i = 0; i < 16; ++i) acc[j][i] = 0.f;
        float ss = 0.f;
        const float* xr = p.x1 + (size_t)(t0 + i32) * D_;
        f16* xmr = p.xm + (size_t)(t0 + i32) * D_;
        for (int kb = wid * 256; kb < wid * 256 + 256; kb += 8) {
            const int k0 = kb + 4 * kk;
            const f32x4 xv = *(const f32x4*)(xr + k0);
            const f32x4 gv = *(const f32x4*)(p.ln2 + k0);
            ss += xv[0] * xv[0] + xv[1] * xv[1] + xv[2] * xv[2] + xv[3] * xv[3];
            f32x4 av; av[0] = xv[0] * gv[0]; av[1] = xv[1] * gv[1]; av[2] = xv[2] * gv[2]; av[3] = xv[3] * gv[3];
            half4 hv; hv[0] = (f16)av[0]; hv[1] = (f16)av[1]; hv[2] = (f16)av[2]; hv[3] = (f16)av[3];
            *(half4*)(xmr + k0) = hv;
#pragma unroll
            for (int e = 0; e < 4; ++e) {
#pragma unroll
                for (int j = 0; j < 3; ++j) {
                    const float b = router_w(p, k0 + e, 32 * j + i32);
                    acc[j] = __builtin_amdgcn_mfma_f32_32x32x2f32(av[e], b, acc[j], 0, 0, 0);
                }
            }
        }
        __syncthreads();
#pragma unroll
        for (int j = 0; j < 3; ++j)
#pragma unroll
            for (int i = 0; i < 16; ++i) part[((wid * 3 + j) * 16 + i) * 64 + lane] = acc[j][i];
        ssq[wid * 64 + lane] = ss;
        __syncthreads();
        if (tid < 32) {
            float s = 0.f;
#pragma unroll
            for (int w = 0; w < 8; ++w) s += ssq[w * 64 + tid] + ssq[w * 64 + 32 + tid];
            const float rs = 1.0f / sqrtf(s * (1.0f / D_) + 1e-6f);
            rstd_s[tid] = rs; p.rstd2[t0 + tid] = rs;
        }
        __syncthreads();
        for (int idx = tid; idx < 32 * 72; idx += NTHR) {
            const int tok = idx / 72, c = idx % 72, j = c >> 5, col = c & 31;
            const int hh = (tok >> 2) & 1, reg = (tok & 3) + 4 * (tok >> 3), ln = col + 32 * hh;
            float s = 0.f;
#pragma unroll
            for (int w = 0; w < 8; ++w) s += part[((w * 3 + j) * 16 + reg) * 64 + ln];
            logit[tok * 72 + c] = s * rstd_s[tok] + (c < 8 ? p.b_rg[c] : p.b_re[c - 8]);
        }
        __syncthreads();
        if (tid < 32) {
            const float* lg = logit + tid * 72;
            int gi = 0; float gm = lg[0];
#pragma unroll
            for (int g = 1; g < 8; ++g) if (lg[g] > gm) { gm = lg[g]; gi = g; }
            float se = 0.f;
#pragma unroll
            for (int g = 0; g < 8; ++g) se += expf(lg[g] - gm);
            const float pg = 1.0f / se;
            const float* el = lg + 8 + gi * 8;
            int e0 = 0; float v0 = el[0];
#pragma unroll
            for (int j = 1; j < 8; ++j) if (el[j] > v0) { v0 = el[j]; e0 = j; }
            int e1 = -1; float v1 = -INFINITY;
#pragma unroll
            for (int j = 0; j < 8; ++j) if (j != e0 && el[j] > v1) { v1 = el[j]; e1 = j; }
            const float w1 = 1.0f / (1.0f + expf(v0 - v1)), w0 = 1.0f - w1;
            const int t = t0 + tid;
            p.eid[2 * t] = gi * 8 + e0; p.eid[2 * t + 1] = gi * 8 + e1;
            p.gate[2 * t] = pg * w0; p.gate[2 * t + 1] = pg * w1;
        }
        __syncthreads();
    }
}

__device__ __forceinline__ void phase_lists(const Params& p, char* smem) {
    int* wcnt = (int*)smem;
    const int tid = threadIdx.x, lane = tid & 63, wid = tid >> 6;
    for (int e = blockIdx.x; e < NEXP; e += gridDim.x) {
        int base = 0;
        for (int a0 = 0; a0 < 2 * T_; a0 += NTHR) {
            const int a = a0 + tid;
            const bool f = p.eid[a] == e;
            const unsigned long long m = __ballot(f);
            const int pre = __popcll(m & ((1ull << lane) - 1ull));
            __syncthreads();
            if (lane == 0) wcnt[wid] = __popcll(m);
            __syncthreads();
            int off = 0, tot = 0;
#pragma unroll
            for (int w = 0; w < 8; ++w) { const int cw = wcnt[w]; if (w < wid) off += cw; tot += cw; }
            if (f) p.list[e * T_ + base + off + pre] = a;
            base += tot;
        }
        if (tid == 0) p.cnt[e] = base;
        __syncthreads();
    }
}

__device__ __forceinline__ float silu_f(float v) { return v / (1.0f + expf(-v)); }

__device__ __forceinline__ void moe_tables(const Params& p, int* tab) {
    if (threadIdx.x == 0) {
        int a = 0, b = 0;
        for (int e = 0; e < NEXP; ++e) { tab[e] = a; tab[65 + e] = b; const int c = p.cnt[e]; a += (c + 127) >> 7; b += c; }
        tab[64] = a; tab[129] = b;
    }
    __syncthreads();
}

__device__ __forceinline__ void phase_moe_gu(const Params& p, char* smem) {
    int* tab = (int*)(smem + 64 * 1024);
    moe_tables(p, tab);
    const int tid = threadIdx.x;
    const int total = tab[64] * 12;
    for (int u = blockIdx.x; u < total; u += gridDim.x) {
        const int mtg = u / 12, nt = u % 12;
        int e = 0;
        while (tab[e + 1] <= mtg) ++e;
        const int mt = mtg - tab[e], cnt = p.cnt[e], rowoff = tab[65 + e];
        const int* lst = p.list + e * T_;
        const f16* ap[2]; const f16* bp[2] = {nullptr, nullptr};
#pragma unroll
        for (int i = 0; i < 2; ++i) {
            int row = mt * 128 + ch_row<64>(i); if (row >= cnt) row = cnt - 1;
            const int tok = lst[row] >> 1;
            ap[i] = p.xm + (size_t)tok * D_ + ch_col<64>(i);
        }
        const int ng = tid & 31;
        const int colB = ((ng >> 3) & 1) * DE + nt * 64 + 32 * (ng >> 4) + 4 * (ng & 7);
        const float* wB = p.w_gu + (size_t)e * D_ * (2 * DE) + colB;
        f16* Hb = p.Hbuf; const float* rs2 = p.rstd2;
        gemm_tile<64, true>(smem, D_, ap, bp, wB, 2 * DE, [=](int ml, int nl, const f32x16& cg, const f32x16& cu) {
            const int row = mt * 128 + ml;
            if (row < cnt) {
                const float rs = rs2[lst[row] >> 1];
                const int wn = nl >> 6, h4 = nl & 63;
#pragma unroll
                for (int g = 0; g < 4; ++g) {
                    half4 hv;
#pragma unroll
                    for (int e2 = 0; e2 < 4; ++e2) { const float gg = cg[4 * g + e2] * rs, uu = cu[4 * g + e2] * rs; hv[e2] = (f16)(silu_f(gg) * uu); }
                    *(half4*)(Hb + (size_t)(rowoff + row) * DE + nt * 64 + 32 * wn + 8 * g + h4) = hv;
                }
            }
        });
    }
}

__device__ __forceinline__ void phase_moe_dn(const Params& p, char* smem) {
    int* tab = (int*)(smem + 64 * 1024);
    moe_tables(p, tab);
    const int tid = threadIdx.x;
    const int total = tab[64] * 16;
    for (int u = blockIdx.x; u < total; u += gridDim.x) {
        const int mtg = u / 16, nt = u % 16;
        int e = 0;
        while (tab[e + 1] <= mtg) ++e;
        const int mt = mtg - tab[e], cnt = p.cnt[e], rowoff = tab[65 + e];
        const int* lst = p.list + e * T_;
        const f16* ap[2]; const f16* bp[2] = {nullptr, nullptr};
#pragma unroll
        for (int i = 0; i < 2; ++i) {
            int row = mt * 128 + ch_row<64>(i); if (row >= cnt) row = cnt - 1;
            ap[i] = p.Hbuf + (size_t)(rowoff + row) * DE + ch_col<64>(i);
        }
        const int ng = tid & 31;
        const float* wB = p.w_dn + (size_t)e * DE * D_ + nt * 128 + 4 * ng;
        float* Y2 = p.Y2; const float* gate = p.gate;
        gemm_tile<64, true>(smem, DE, ap, bp, wB, D_, [=](int ml, int nl, const f32x16& c0, const f32x16& c1) {
            const int row = mt * 128 + ml;
            if (row < cnt) {
                const int a = lst[row]; const float gt = gate[a];
                auto st = [&](const f32x16& c, int j) {
#pragma unroll
                    for (int g = 0; g < 4; ++g) {
                        f32x4 o; o[0] = c[4 * g] * gt; o[1] = c[4 * g + 1] * gt; o[2] = c[4 * g + 2] * gt; o[3] = c[4 * g + 3] * gt;
                        *(f32x4*)(Y2 + (size_t)a * D_ + nt * 128 + nl + 32 * j + 8 * g) = o;
                    }
                };
                st(c0, 0); st(c1, 1);
            }
        });
    }
}

__device__ __forceinline__ void phase_final(const Params& p, char* smem) {
    const int tid = threadIdx.x, lane = tid & 63, wid = tid >> 6;
    for (int t = blockIdx.x * 8 + wid; t < T_; t += gridDim.x * 8) {
        f32x4 v[8]; float ss = 0.f;
#pragma unroll
        for (int i = 0; i < 8; ++i) {
            const int c = lane * 4 + i * 256;
            const f32x4 a = *(const f32x4*)(p.x1 + (size_t)t * D_ + c);
            const f32x4 b = *(const f32x4*)(p.Y2 + (size_t)(2 * t) * D_ + c);
            const f32x4 d = *(const f32x4*)(p.Y2 + (size_t)(2 * t + 1) * D_ + c);
            v[i] = a + b + d;
            ss += v[i][0] * v[i][0] + v[i][1] * v[i][1] + v[i][2] * v[i][2] + v[i][3] * v[i][3];
        }
        ss = wave_sum(ss);
        const float rs = 1.0f / sqrtf(ss * (1.0f / D_) + 1e-6f);
#pragma unroll
        for (int i = 0; i < 8; ++i) {
            const int c = lane * 4 + i * 256;
            const f32x4 g = *(const f32x4*)(p.ln_f + c);
            f32x4 o; o[0] = v[i][0] * rs * g[0]; o[1] = v[i][1] * rs * g[1]; o[2] = v[i][2] * rs * g[2]; o[3] = v[i][3] * rs * g[3];
            *(f32x4*)(p.out + (size_t)t * D_ + c) = o;
        }
    }
}

extern __shared__ __attribute__((aligned(16))) char dyn_smem[];
__global__ void __launch_bounds__(NTHR, 2) mega(Params p) {
    char* smem = dyn_smem;
    volatile LAS unsigned* xbw = (volatile LAS unsigned*)(dyn_smem + LDS_BYTES - 16);
    if (threadIdx.x == 0) { xbw[0] = 0u; xbw[1] = 0u; xbw[2] = 0u; xbw[3] = 0u; }
    __syncthreads();
    XcdBarrier bar = xcd_barrier_post(p.bar, xbw);
    phase_prologue(p, smem);
    xcd_barrier(bar);
    phase_inproj(p, smem);
    xcd_barrier(bar);
    phase_prepA(p, smem);
    xcd_barrier(bar);
    phase_lora(p, smem);
    xcd_barrier(bar);
    phase_prepB(p, smem);
    xcd_barrier(bar);
    phase_scan1(p, smem);
    xcd_barrier(bar);
    phase_scan2(p, smem);
    phase_attn(p, smem);
    xcd_barrier(bar);
    phase_scan3(p, smem);
    xcd_barrier(bar);
    phase_rwkvout(p, smem);
    xcd_barrier(bar);
    phase_outproj(p, smem);
    xcd_barrier(bar);
    phase_router(p, smem);
    xcd_barrier(bar);
    phase_lists(p, smem);
    xcd_barrier(bar);
    phase_moe_gu(p, smem);
    xcd_barrier(bar);
    phase_moe_dn(p, smem);
    xcd_barrier(bar);
    phase_final(p, smem);
}

static inline size_t align_up(size_t v, size_t a) { return (v + a - 1) / a * a; }

extern "C" void kernel_launch(void* const* d_in, const int* in_sizes, int n_in, void* d_out, int out_size, void* d_ws, size_t ws_size, hipStream_t stream) {
    Params p{};
    p.x = (const float*)d_in[0]; p.pos = (const int*)d_in[1]; p.ln1 = (const float*)d_in[2]; p.w_in = (const float*)d_in[3]; p.mu = (const float*)d_in[4];
    p.w_decay0 = (const float*)d_in[5]; p.w_decay_up = (const float*)d_in[6]; p.a0 = (const float*)d_in[7]; p.w_a_up = (const float*)d_in[8]; p.w_g_up = (const float*)d_in[9];
    p.k_k = (const float*)d_in[10]; p.k_a = (const float*)d_in[11]; p.r_k = (const float*)d_in[12]; p.gn_w = (const float*)d_in[13]; p.gn_b = (const float*)d_in[14];
    p.sinks = (const float*)d_in[15]; p.w_out = (const float*)d_in[16]; p.ln2 = (const float*)d_in[17]; p.w_rg = (const float*)d_in[18]; p.b_rg = (const float*)d_in[19];
    p.w_re = (const float*)d_in[20]; p.b_re = (const float*)d_in[21]; p.w_gu = (const float*)d_in[22]; p.w_dn = (const float*)d_in[23]; p.ln_f = (const float*)d_in[24];
    p.out = (float*)d_out;
    char* ws = (char*)d_ws; size_t off = 0;
    auto take = [&](size_t bytes) { char* r = ws + off; off = align_up(off + bytes, 256); return r; };
    p.bar = (unsigned*)take(64 * 1024);
    p.xh = (f16*)take((size_t)T_ * D_ * 2); p.rstd1 = (float*)take(T_ * 4);
    p.WinT = (f16*)take((size_t)NINP * D_ * 2); p.WoutT = (f16*)take((size_t)D_ * D_ * 2);
    p.WduT = (f16*)take(RW * 64 * 2); p.WauT = (f16*)take(RW * 64 * 2); p.WguT = (f16*)take(RW * 160 * 2);
    p.ropec = (float*)take(T_ * 32 * 4); p.ropes = (float*)take(T_ * 32 * 4);
    p.P = (f16*)take((size_t)T_ * NINP * 2);
    p.td = (f16*)take(T_ * 64 * 2); p.ad = (f16*)take(T_ * 64 * 2); p.sg = (f16*)take(T_ * 160 * 2);
    p.qr = (f16*)take((size_t)T_ * 1024 * 2); p.kr = (f16*)take((size_t)T_ * 256 * 2);
    p.Wd = (float*)take((size_t)T_ * RW * 4); p.Aa = (float*)take((size_t)T_ * RW * 4); p.G = (f16*)take((size_t)T_ * RW * 2);
    p.R = (float*)take((size_t)T_ * RW * 4); p.K2 = (float*)take((size_t)T_ * RW * 4); p.V = (float*)take((size_t)T_ * RW * 4);
    p.A = (float*)take((size_t)T_ * RW * 4); p.B = (float*)take((size_t)T_ * RW * 4); p.bonus = (float*)take(T_ * NH * 4);
    p.segP = (float*)take((size_t)NH * NSEG * 4096 * 4); p.segQ = (float*)take((size_t)NH * NSEG * 4096 * 4); p.Sst = (float*)take((size_t)NH * NSEG * 4096 * 4);
    p.yraw = (float*)take((size_t)T_ * RW * 4); p.ycat = (f16*)take((size_t)T_ * D_ * 2);
    p.x1 = (float*)take((size_t)T_ * D_ * 4); p.xm = (f16*)take((size_t)T_ * D_ * 2); p.rstd2 = (float*)take(T_ * 4);
    p.eid = (int*)take(2 * T_ * 4); p.gate = (float*)take(2 * T_ * 4); p.cnt = (int*)take(NEXP * 4); p.list = (int*)take((size_t)NEXP * T_ * 4);
    p.Hbuf = (f16*)take((size_t)2 * T_ * DE * 2); p.Y2 = (float*)take((size_t)2 * T_ * D_ * 4);

    static int grid = 0;
    if (!grid) {
        int dev = 0, cus = 0, per_cu = 0;
        (void)hipGetDevice(&dev);
        (void)hipDeviceGetAttribute(&cus, hipDeviceAttributeMultiprocessorCount, dev);
        (void)hipFuncSetAttribute((const void*)mega, hipFuncAttributeMaxDynamicSharedMemorySize, LDS_BYTES);
        (void)hipOccupancyMaxActiveBlocksPerMultiprocessor(&per_cu, mega, NTHR, LDS_BYTES);
        if (per_cu < 1) per_cu = 1;
        grid = cus * 1;
        if (grid <= 0) grid = 256;
    }
    (void)hipMemsetAsync(p.bar, 0, 64 * 1024, stream);
    mega<<<dim3(grid), dim3(NTHR), LDS_BYTES, stream>>>(p);
}
```

```cpp
#include <hip/hip_runtime.h>
#include <stdint.h>
#include <type_traits>

typedef _Float16 f16;
typedef _Float16 half8 __attribute__((ext_vector_type(8)));
typedef _Float16 half4 __attribute__((ext_vector_type(4)));
typedef _Float16 half2v __attribute__((ext_vector_type(2)));
typedef float f32x16 __attribute__((ext_vector_type(16)));
typedef float f32x4 __attribute__((ext_vector_type(4)));
typedef unsigned u32x4 __attribute__((ext_vector_type(4)));
typedef const __attribute__((address_space(4))) float* cfp;

#define T_ 8192
#define D_ 2048
#define NIN 4896
#define NINP 5120
#define RW 1024
#define NH 16
#define C_R 0
#define C_K 1024
#define C_V 2048
#define C_WD 3072
#define C_AD 3136
#define C_GD 3200
#define C_AQ 3360
#define C_AK 4384
#define C_AV 4640
#define NSEG 64
#define SEGL 128
#define DE 768
#define NEXP 64
#define NTHR 512
#define LDS_BYTES (150 * 1024)

struct Params {
    const float* x; const int* pos; const float* ln1; const float* w_in; const float* mu; const float* w_decay0; const float* w_decay_up;
    const float* a0; const float* w_a_up; const float* w_g_up; const float* k_k; const float* k_a; const float* r_k; const float* gn_w; const float* gn_b;
    const float* sinks; const float* w_out; const float* ln2; const float* w_rg; const float* b_rg; const float* w_re; const float* b_re;
    const float* w_gu; const float* w_dn; const float* ln_f;
    float* out;
    unsigned* bar;
    float* Wr; f16* WrH; f16* WrL; f16* xh; float* rstd1; f16* WinT; f16* WoutT; f16* WduT; f16* WauT; f16* WguT; float* ropec; float* ropes;
    f16* P; f16* qr; f16* kr;
    float* Wd; f16* G; f16* R; f16* K2; f16* V; f16* A; f16* B; float* bonus;
    f16* PT; f16* segQ; f16* Sst; f16* ycat; float* x1; f16* xm; float* rstd2;
    int* eid; float* gate; int* cnt; int* list; f16* Hbuf; f16* Y2; f16* Wdn16;
};


#define XB_TMO      128
#define XB_XCNT(j)  (256  + 64 * (j))
#define XB_XSUB(j)  (1280 + 64 * (j))
#define XB_XGEN(j)  (2304 + 64 * (j))
#define XB_TOP      3328
#define XB_TOPGEN   3392
#define XCD_BAR_WORDS 3456
#define XB_SPIN_CAP (1u << 18)
#define LAS __attribute__((address_space(3)))

__device__ __forceinline__ unsigned xb_ld(unsigned* p)              { return __hip_atomic_load(p, __ATOMIC_RELAXED, __HIP_MEMORY_SCOPE_AGENT); }
__device__ __forceinline__ unsigned xb_add(unsigned* p, unsigned v) { return __hip_atomic_fetch_add(p, v, __ATOMIC_RELAXED, __HIP_MEMORY_SCOPE_AGENT); }
__device__ __forceinline__ unsigned xb_xcc_id() { return (unsigned)__builtin_amdgcn_s_getreg((3 << 11) | 20) & 0xFu; }
#define XB_SPIN(cond, bar) do { unsigned _sp = 0; while (cond) { __builtin_amdgcn_s_sleep(1); \
    if ((++_sp & 255u) == 0u) { if (xb_ld(&(bar)[XB_TMO])) break; if (_sp > XB_SPIN_CAP) { atomicAdd(&(bar)[XB_TMO], 1u); break; } } } } while (0)

struct XcdBarrier { unsigned* bar; unsigned x; volatile LAS unsigned* st; };

__device__ __forceinline__ XcdBarrier xcd_barrier_post(unsigned* bar, volatile LAS unsigned* st) {
    XcdBarrier b; b.bar = bar; b.x = xb_xcc_id(); b.st = st;
    if (threadIdx.x == 0) (void)xb_add(&bar[XB_XCNT(b.x)], 1u);
    return b;
}
__device__ __forceinline__ void xcd_barrier_complete(unsigned* bar, unsigned x, unsigned& nloc, unsigned& nx) {
    const unsigned G = gridDim.x * gridDim.y * gridDim.z;
    unsigned sum, cnt, mine, sp = 0u;
    for (;;) {
        sum = 0u; cnt = 0u; mine = 0u;
#pragma unroll
        for (unsigned j = 0; j < 16; ++j) { const unsigned c = xb_ld(&bar[XB_XCNT(j)]); sum += c; cnt += (c > 0u) ? 1u : 0u; mine = (j == x) ? c : mine; }
        if (sum == G) break;
        __builtin_amdgcn_s_sleep(1);
        if ((++sp & 255u) == 0u) { if (xb_ld(&bar[XB_TMO])) break; if (sp > XB_SPIN_CAP) { atomicAdd(&bar[XB_TMO], 1u); break; } }
    }
    nloc = mine > 0u ? mine : 1u; nx = cnt > 0u ? cnt : 1u;
}
__device__ __forceinline__ void xcd_barrier(const XcdBarrier& b) {
    asm volatile("s_waitcnt vmcnt(0)" ::: "memory");
    __syncthreads();
    if (threadIdx.x == 0) {
        unsigned* bar = b.bar;
        __builtin_amdgcn_s_waitcnt(0);
        unsigned nloc = b.st[0], nx = b.st[1];
        if (nloc == 0u) { xcd_barrier_complete(bar, b.x, nloc, nx); b.st[0] = nloc; b.st[1] = nx; }
        const unsigned old = xb_add(&bar[XB_XSUB(b.x)], 1u);
        const unsigned gen = old / nloc;
        if (old + 1u == (gen + 1u) * nloc) {
            __builtin_amdgcn_fence(__ATOMIC_RELEASE, "agent");
            asm volatile("s_waitcnt vmcnt(0)" ::: "memory");
            const unsigned og = xb_add(&bar[XB_TOP], 1u);
            const unsigned tg = og / nx;
            if (og + 1u == (tg + 1u) * nx) xb_add(&bar[XB_TOPGEN], 1u);
            else XB_SPIN(xb_ld(&bar[XB_TOPGEN]) == tg, bar);
            __builtin_amdgcn_fence(__ATOMIC_ACQUIRE, "agent");
            xb_add(&bar[XB_XGEN(b.x)], 1u);
            asm volatile("s_waitcnt vmcnt(0)" ::: "memory");
        } else {
            XB_SPIN(xb_ld(&bar[XB_XGEN(b.x)]) == gen, bar);
            __builtin_amdgcn_fence(__ATOMIC_ACQUIRE, "agent");
            asm volatile("s_waitcnt vmcnt(0)" ::: "memory");
        }
    }
    __syncthreads();
}

#define WAVE_LDS_SYNC() asm volatile("s_waitcnt lgkmcnt(0)" ::: "memory")
__device__ __forceinline__ int phase_tid() { int t = threadIdx.x; asm volatile("" : "+v"(t)); return t; }

__device__ __forceinline__ float wave_sum(float v) {
#pragma unroll
    for (int o = 32; o > 0; o >>= 1) v += __shfl_xor(v, o);
    return v;
}

__device__ __forceinline__ void transpose_cvt(char* smem, const float* src, int K, int N, int Npad, f16* dst, int bid, int nb) {
    float* t = (float*)smem;
    const int tid = phase_tid();
    const int ktiles = (K + 63) / 64, ntiles = Npad / 64;
    for (int tile = bid; tile < ktiles * ntiles; tile += nb) {
        const int kb = tile % ktiles, nbk = tile / ktiles;
        __syncthreads();
        {
            const int n_l = tid & 63, k_l0 = tid >> 6;
#pragma unroll
            for (int i = 0; i < 8; ++i) {
                const int k_l = k_l0 + 8 * i, k = kb * 64 + k_l, n = nbk * 64 + n_l;
                float v = 0.f;
                if (k < K && n < N) v = src[(size_t)k * N + n];
                t[k_l * 65 + n_l] = v;
            }
        }
        __syncthreads();
        {
            const int k_l = tid & 63, n_l0 = tid >> 6;
#pragma unroll
            for (int i = 0; i < 8; ++i) {
                const int n_l = n_l0 + 8 * i, k = kb * 64 + k_l, n = nbk * 64 + n_l;
                if (k < K) dst[(size_t)n * K + k] = (f16)t[k_l * 65 + n_l];
            }
        }
    }
}

__device__ __forceinline__ void transpose_cvt_fast(char* smem, const float* src, int K, int N, int Npad, f16* dst, int bid, int nb) {
    const int tid = phase_tid(), lane = tid & 63, wid = tid >> 6;
    const int kgB = (wid >> 1) * 4 + (lane & 3), ngl = lane >> 2, nB = 64 * (wid & 1) + 4 * ngl;
    const int ktiles = K / 64, ntiles = Npad / 128;
    for (int tile = bid; tile < ktiles * ntiles; tile += nb) {
        const int kb = tile % ktiles, nbk = tile / ktiles, k0 = kb * 64, n0 = nbk * 128;
        f32x4 w[4];
#pragma unroll
        for (int j = 0; j < 4; ++j) {
            w[j] = (f32x4){0.f, 0.f, 0.f, 0.f};
            if (n0 + nB < N) w[j] = *(const f32x4*)(src + (size_t)(k0 + 4 * kgB + j) * N + n0 + nB);
        }
        __syncthreads();
#pragma unroll
        for (int ni = 0; ni < 4; ++ni) {
            const int n = nB + ni;
            half4 hv; hv[0] = (f16)w[0][ni]; hv[1] = (f16)w[1][ni]; hv[2] = (f16)w[2][ni]; hv[3] = (f16)w[3][ni];
            *(half4*)(smem + n * 128 + ((((kgB >> 1) ^ ((n >> 1) & 7))) << 4) + (kgB & 1) * 8) = hv;
        }
        __syncthreads();
#pragma unroll
        for (int i = 0; i < 2; ++i) {
            const int c = tid + NTHR * i, nl = c >> 3, cc = c & 7;
            *(u32x4*)(dst + (size_t)(n0 + nl) * K + k0 + cc * 8) = *(const u32x4*)(smem + nl * 128 + ((cc ^ ((nl >> 1) & 7)) << 4));
        }
    }
}

__device__ __forceinline__ void phase_prologue(const Params& p, char* smem) {
    const int tid = phase_tid(), lane = tid & 63, wid = tid >> 6, bid = blockIdx.x, nb = gridDim.x;
    for (int row = bid * 8 + wid; row < T_; row += nb * 8) {
        const float* xr = p.x + (size_t)row * D_;
        float ss = 0.f;
#pragma unroll
        for (int i = 0; i < 8; ++i) {
            const int c = lane * 4 + i * 256;
            const f32x4 v = *(const f32x4*)(xr + c);
            const f32x4 g = *(const f32x4*)(p.ln1 + c);
            ss += v[0] * v[0] + v[1] * v[1] + v[2] * v[2] + v[3] * v[3];
            half4 hv; hv[0] = (f16)(v[0] * g[0]); hv[1] = (f16)(v[1] * g[1]); hv[2] = (f16)(v[2] * g[2]); hv[3] = (f16)(v[3] * g[3]);
            *(half4*)(p.xh + (size_t)row * D_ + c) = hv;
        }
        ss = wave_sum(ss);
        if (lane == 0) p.rstd1[row] = 1.0f / sqrtf(ss * (1.0f / D_) + 1e-6f);
    }
    transpose_cvt_fast(smem, p.w_in, D_, NIN, NINP, p.WinT, bid, nb);
    for (int idx = bid * NTHR + tid; idx < NH * 2 * 18 * 64; idx += nb * NTHR) {
        const int ln = idx & 63, f = idx >> 6, s18 = f % 18, hj = f / 18;
        const int ch = (hj >> 1) * 64 + 32 * (hj & 1) + (ln & 31), hq = ln >> 5;
        const float* src; int s; f16* dst;
        if (s18 < 10) { src = p.w_g_up; s = s18; dst = p.WguT + ((size_t)(hj * 10 + s) * 64 + ln) * 8; }
        else if (s18 < 14) { src = p.w_decay_up; s = s18 - 10; dst = p.WduT + ((size_t)(hj * 4 + s) * 64 + ln) * 8; }
        else { src = p.w_a_up; s = s18 - 14; dst = p.WauT + ((size_t)(hj * 4 + s) * 64 + ln) * 8; }
        half8 o;
#pragma unroll
        for (int e = 0; e < 8; ++e) o[e] = (f16)src[(size_t)(16 * s + 8 * hq + e) * RW + ch];
        *(half8*)dst = o;
    }
}

__device__ __forceinline__ void phase_deferred(const Params& p, char* smem, int bid, int nb) {
    const int tid = phase_tid();
    transpose_cvt_fast(smem, p.w_out, D_, D_, D_, p.WoutT, bid, nb);
    for (int idx = bid * NTHR + tid; idx < D_ * 96; idx += nb * NTHR) {
        const int c = idx / D_, k = idx % D_;
        const float w = c < 8 ? p.w_rg[k * 8 + c] : (c < 72 ? p.w_re[k * 64 + (c - 8)] : 0.f);
        const f16 hi = (f16)w;
        p.WrH[idx] = hi; p.WrL[idx] = (f16)((w - (float)hi) * 2048.0f);
    }
    {
        const double inv = pow(10000.0, -(double)(tid & 31) / 32.0);
        for (int idx = bid * NTHR + tid; idx < T_ * 32; idx += nb * NTHR) {
            const int t = idx >> 5;
            double ang = (double)p.pos[t] * inv;
            ang -= 6.283185307179586476925 * rint(ang * 0.15915494309189533577);
            const float af = (float)ang;
            p.ropec[idx] = cosf(af); p.ropes[idx] = sinf(af);
        }
    }
}

template <int BK> struct GemmCfg { static constexpr int STRIDE = BK * 2 + 16; static constexpr int NCH = BK / 32; static constexpr int B_OFF = 128 * STRIDE; };

template <int BK, bool BF32, class Epi>
__device__ __forceinline__ void gemm_tile(char* smem, int K, const f16* const (&aptr)[GemmCfg<BK>::NCH], const f16* const (&bptr)[GemmCfg<BK>::NCH],
                                          const float* wB, int ldw, const Epi& epi) {
    constexpr int STRIDE = GemmCfg<BK>::STRIDE, NCH = GemmCfg<BK>::NCH, B_OFF = GemmCfg<BK>::B_OFF;
    const int tid = phase_tid(), lane = tid & 63, wid = tid >> 6, wm = wid >> 1, wn = wid & 1, r = lane & 31, h = lane >> 5;
    char* As = smem; char* Bs = smem + B_OFF;
    f32x16 acc0, acc1;
#pragma unroll
    for (int i = 0; i < 16; ++i) { acc0[i] = 0.f; acc1[i] = 0.f; }
    u32x4 ra[NCH], rb[NCH]; f32x4 rw[4];
    int aoff[NCH];
#pragma unroll
    for (int i = 0; i < NCH; ++i) { const int c = tid + NTHR * i; aoff[i] = (c / (BK / 8)) * STRIDE + (c % (BK / 8)) * 16; }
    const int nk = K / BK;
#pragma unroll
    for (int i = 0; i < NCH; ++i) ra[i] = *(const u32x4*)(aptr[i]);
    if constexpr (BF32) {
#pragma unroll
        for (int j = 0; j < 4; ++j) rw[j] = *(const f32x4*)(wB + (size_t)(4 * (tid >> 5) + j) * ldw);
    } else {
#pragma unroll
        for (int i = 0; i < NCH; ++i) rb[i] = *(const u32x4*)(bptr[i]);
    }
    for (int kt = 0; kt < nk; ++kt) {
        __syncthreads();
#pragma unroll
        for (int i = 0; i < NCH; ++i) *(u32x4*)(As + aoff[i]) = ra[i];
        if constexpr (BF32) {
            const int ng = tid & 31, kg = tid >> 5;
#pragma unroll
            for (int ni = 0; ni < 4; ++ni) {
                half4 hv; hv[0] = (f16)rw[0][ni]; hv[1] = (f16)rw[1][ni]; hv[2] = (f16)rw[2][ni]; hv[3] = (f16)rw[3][ni];
                *(half4*)(Bs + (4 * ng + ni) * STRIDE + kg * 8) = hv;
            }
        } else {
#pragma unroll
            for (int i = 0; i < NCH; ++i) *(u32x4*)(Bs + aoff[i]) = rb[i];
        }
        __syncthreads();
        if (kt + 1 < nk) {
            const int k0 = (kt + 1) * BK;
#pragma unroll
            for (int i = 0; i < NCH; ++i) ra[i] = *(const u32x4*)(aptr[i] + k0);
            if constexpr (BF32) {
#pragma unroll
                for (int j = 0; j < 4; ++j) rw[j] = *(const f32x4*)(wB + (size_t)(k0 + 4 * (tid >> 5) + j) * ldw);
            } else {
#pragma unroll
                for (int i = 0; i < NCH; ++i) rb[i] = *(const u32x4*)(bptr[i] + k0);
            }
        }
#pragma unroll
        for (int s = 0; s < BK / 16; ++s) {
            const half8 a = *(const half8*)(As + (32 * wm + r) * STRIDE + (16 * s + 8 * h) * 2);
            const half8 b0 = *(const half8*)(Bs + (64 * wn + r) * STRIDE + (16 * s + 8 * h) * 2);
            const half8 b1 = *(const half8*)(Bs + (64 * wn + 32 + r) * STRIDE + (16 * s + 8 * h) * 2);
            acc0 = __builtin_amdgcn_mfma_f32_32x32x16_f16(b0, a, acc0, 0, 0, 0);
            acc1 = __builtin_amdgcn_mfma_f32_32x32x16_f16(b1, a, acc1, 0, 0, 0);
        }
    }
    epi(32 * wm + r, 64 * wn + 4 * h, acc0, acc1);
}

template <int BK> __device__ __forceinline__ int ch_row(int i) { return (threadIdx.x + NTHR * i) / (BK / 8); }
template <int BK> __device__ __forceinline__ int ch_col(int i) { return ((threadIdx.x + NTHR * i) % (BK / 8)) * 8; }

namespace pg8 {
#define PG8_LAS __attribute__((address_space(3)))
typedef unsigned short bf16_t;
typedef _Float16 bf16x8 __attribute__((ext_vector_type(8)));
typedef float f32x4 __attribute__((ext_vector_type(4)));
typedef unsigned u32x4 __attribute__((ext_vector_type(4)));
constexpr int BM = 256, BK = 64, HALF = 128, HTB = HALF * BK * 2  , STAGE_BYTES = 8 * HTB, NXCD = 8, WGM = 8;

__host__ __device__ __forceinline__ int lds_byte(int r, int c) { const int st = (r >> 4) * 2 + (c >> 5), rr = r & 15, cc = c & 31, ob = rr * 64 + cc * 2; return st * 1024 + (ob ^ (((ob >> 9) & 1) << 5)); }
__host__ __device__ __forceinline__ void stage_rc(int b, int& R, int& C) { const int st = b / 1024, sb = b % 1024, swz = sb ^ (((sb >> 9) & 1) << 5); R = (st >> 1) * 16 + swz / 64; C = (st & 1) * 32 + (swz % 64) / 2; }
__host__ __device__ __forceinline__ int perm32(int rho) { const int n = rho >> 4, i = rho & 15; return 8 * (i >> 2) + 4 * n + (i & 3); }

struct Unit { int pm, pn; };
struct Gemm { const bf16_t* A; const bf16_t* Bt; int M, N, K; };

struct StaticOrder {
    int nM, nN, nwg, G, c;
    __host__ __device__ void init(int M, int N, int G_, int c_) { nM = M / BM; nN = N / BM; nwg = nM * nN; G = G_; c = c_; }
    __host__ __device__ bool next(int i, Unit& u) const {
        const long L = (long)i * G + c; if (L >= nwg) return false;
        int wgid = (int)L; { const int q = nwg / NXCD, r = nwg % NXCD, xcd = wgid % NXCD, off = wgid / NXCD; wgid = (xcd < r ? xcd * (q + 1) : r * (q + 1) + (xcd - r) * q) + off; }
        const int nig = WGM * nN, gid = wgid / nig, fm = gid * WGM, gsz = (nM - fm) < WGM ? (nM - fm) : WGM;
        u.pm = fm + ((wgid % nig) % gsz); u.pn = (wgid % nig) / gsz; return true;
    }
    __device__ __forceinline__ void a_ready(const Unit&) const {}
    __device__ __forceinline__ void done(const Unit&) const {}
};
struct EpiRowScaleF16 {
    static constexpr bool PERM = true, AFTER_DRAIN = false;
    _Float16* __restrict__ O; int ldc; const float* __restrict__ rowscale;
    __device__ __forceinline__ void operator()(const f32x4 (&acc)[2][2][4][2], const Unit& u, int wr, int wc, int fr, int fq) const {
        typedef _Float16 h8 __attribute__((ext_vector_type(8)));
        const int row0 = u.pm * BM + wr * 64 + fr, col0 = u.pn * BM + wc * 32 + 8 * fq;
        float scv[2][4];
#pragma unroll
        for (int ai = 0; ai < 2; ++ai)
#pragma unroll
            for (int m = 0; m < 4; ++m) scv[ai][m] = rowscale[row0 + ai * HALF + m * 16];
#pragma unroll
        for (int ai = 0; ai < 2; ++ai)
#pragma unroll
            for (int m = 0; m < 4; ++m) {
                const int row = row0 + ai * HALF + m * 16; const float sc = scv[ai][m];
                _Float16* rowp = O + (size_t)row * ldc + col0;
#pragma unroll
                for (int bj = 0; bj < 2; ++bj) {
                    const f32x4 v0 = acc[ai][bj][m][0], v1 = acc[ai][bj][m][1];
                    h8 w; w[0] = (_Float16)(v0[0] * sc); w[1] = (_Float16)(v0[1] * sc); w[2] = (_Float16)(v0[2] * sc); w[3] = (_Float16)(v0[3] * sc);
                    w[4] = (_Float16)(v1[0] * sc); w[5] = (_Float16)(v1[1] * sc); w[6] = (_Float16)(v1[2] * sc); w[7] = (_Float16)(v1[3] * sc);
                    *(h8*)(rowp + bj * HALF) = w;
                }
            }
    }
};
struct EpiResidualF32 {
    static constexpr bool PERM = false, AFTER_DRAIN = false;
    float* __restrict__ C; const float* __restrict__ base; int ldc;
    __device__ __forceinline__ void operator()(const f32x4 (&acc)[2][2][4][2], const Unit& u, int wr, int wc, int fr, int fq) const {
        const int row0 = u.pm * BM + wr * 64 + fr, col0 = u.pn * BM + wc * 32 + 4 * fq;
#pragma unroll
        for (int ai = 0; ai < 2; ++ai) {
            f32x4 t[4][2][2];
#pragma unroll
            for (int m = 0; m < 4; ++m)
#pragma unroll
                for (int bj = 0; bj < 2; ++bj)
#pragma unroll
                    for (int n = 0; n < 2; ++n) t[m][bj][n] = *(const f32x4*)(base + (size_t)(row0 + ai * HALF + m * 16) * ldc + col0 + bj * HALF + n * 16);
            __builtin_amdgcn_sched_barrier(0);
#pragma unroll
            for (int m = 0; m < 4; ++m)
#pragma unroll
                for (int bj = 0; bj < 2; ++bj)
#pragma unroll
                    for (int n = 0; n < 2; ++n) t[m][bj][n] += acc[ai][bj][m][n];
            __builtin_amdgcn_sched_barrier(0);
#pragma unroll
            for (int m = 0; m < 4; ++m)
#pragma unroll
                for (int bj = 0; bj < 2; ++bj)
#pragma unroll
                    for (int n = 0; n < 2; ++n) *(f32x4*)(C + (size_t)(row0 + ai * HALF + m * 16) * ldc + col0 + bj * HALF + n * 16) = t[m][bj][n];
            __builtin_amdgcn_sched_barrier(0);
        }
    }
};
template <class Epi, class Sched, bool STAMP = false>
__device__ __forceinline__ void gemm_phase(PG8_LAS unsigned char* lds, const Gemm g, const Sched& S, const Epi& E, unsigned long long* stamps) {
    const int tid = ::phase_tid()  , wid = __builtin_amdgcn_readfirstlane(tid >> 6), lane = tid & 63, wr = wid >> 2, wc = wid & 3, fr = lane & 15, fq = lane >> 4;
    const int K = g.K, nt = K / BK;
    int ts_lo = 0, ts_hi = 0, nts = 0; const unsigned long long rt_entry = STAMP ? (unsigned long long)wall_clock64() : 0ull;
#define PG8_STAMP() do { if (STAMP && wid == 0 && nts < 64) { const unsigned long long _c = (unsigned long long)clock64(); \
        ts_lo = (lane == nts) ? (int)(unsigned)_c : ts_lo; ts_hi = (lane == nts) ? (int)(unsigned)(_c >> 32) : ts_hi; ++nts; } } while (0)
    PG8_STAMP();
    unsigned voffA[2], voffB[2];
#pragma unroll
    for (int i = 0; i < 2; ++i) { int R, C; stage_rc(tid * 16 + i * 8192, R, C); const int Rb = Epi::PERM ? ((R & ~31) + perm32(R & 31)) : R;
        voffA[i] = (unsigned)(R * K + C) * 2u; voffB[i] = (unsigned)(Rb * K + C) * 2u; }
    const size_t kstep = (size_t)(BK * 2);
    const size_t hstep = (size_t)HALF * K * 2;
    const size_t tstep = 2 * hstep;
    const unsigned ldsw = (unsigned)wid * 1024u;
    const int aoff = lds_byte(wr * 64 + fr, fq * 8), boff = lds_byte(wc * 32 + fr, fq * 8);
#define PG8_SA(b, h) (((b) * 2 + (h)) * HTB)
#define PG8_SB(b, h) ((4 + (b) * 2 + (h)) * HTB)
#define PG8_STAGE(bufoff, gbase, voff) do { _Pragma("unroll") for (int _i = 0; _i < 2; ++_i) \
        __builtin_amdgcn_global_load_lds((const unsigned*)((const char*)(gbase) + (voff)[_i]), (PG8_LAS unsigned*)(lds + (bufoff) + ldsw + _i * 8192), 16, 0, 0); } while (0)
#define PG8_LDA(dst, b, h) do { _Pragma("unroll") for (int m = 0; m < 4; ++m) _Pragma("unroll") for (int k = 0; k < 2; ++k) dst[m][k] = *(const PG8_LAS bf16x8*)(lds + PG8_SA(b, h) + aoff + m * 2048 + k * 1024); } while (0)
#define PG8_LDB(dst, b, h) do { _Pragma("unroll") for (int n = 0; n < 2; ++n) _Pragma("unroll") for (int k = 0; k < 2; ++k) dst[n][k] = *(const PG8_LAS bf16x8*)(lds + PG8_SB(b, h) + boff + n * 2048 + k * 1024); } while (0)
#define PG8_MMA(ai, bj, At, Bt) do { __builtin_amdgcn_s_setprio(1); _Pragma("unroll") for (int m = 0; m < 4; ++m) _Pragma("unroll") for (int n = 0; n < 2; ++n) _Pragma("unroll") for (int k = 0; k < 2; ++k) \
        acc[ai][bj][m][n] = __builtin_amdgcn_mfma_f32_16x16x32_f16(Bt[n][k], At[m][k], acc[ai][bj][m][n], 0, 0, 0); __builtin_amdgcn_s_setprio(0); } while (0)
#define PG8_WAIT_V(n) asm volatile("s_waitcnt vmcnt(" #n ")" ::: "memory")
#define PG8_WAIT_L(n) asm volatile("s_waitcnt lgkmcnt(" #n ")" ::: "memory")
#define PG8_BAR __builtin_amdgcn_s_barrier()
#define PG8_SCHED __builtin_amdgcn_sched_barrier(0)
    Unit cur, nxt; int ui = 0;
    if (!S.next(0, cur)) return;
    f32x4 acc[2][2][4][2];
#pragma unroll
    for (int a = 0; a < 2; ++a)
#pragma unroll
        for (int b = 0; b < 2; ++b)
#pragma unroll
            for (int m = 0; m < 4; ++m)
#pragma unroll
                for (int n = 0; n < 2; ++n) acc[a][b][m][n] = (f32x4){0.f, 0.f, 0.f, 0.f};
    bf16x8 At[4][2], B0[2][2], B1[2][2];
    const char* cA = (const char*)g.A + (size_t)cur.pm * tstep; const char* cB = (const char*)g.Bt + (size_t)cur.pn * tstep;
    S.a_ready(cur);
    PG8_STAGE(PG8_SB(0, 0), cB, voffB); PG8_STAGE(PG8_SA(0, 0), cA, voffA); PG8_STAGE(PG8_SB(0, 1), cB + hstep, voffB); PG8_STAGE(PG8_SA(0, 1), cA + hstep, voffA);
    if (wr == 1) PG8_BAR;
    PG8_WAIT_V(4); PG8_BAR;
    PG8_STAGE(PG8_SB(1, 0), cB + kstep, voffB); PG8_STAGE(PG8_SA(1, 0), cA + kstep, voffA); PG8_STAGE(PG8_SB(1, 1), cB + hstep + kstep, voffB);
    PG8_WAIT_V(6); PG8_BAR;
    PG8_STAMP();
    for (;;) {
        const bool has_next = S.next(ui + 1, nxt);
        const char* nA = has_next ? (const char*)g.A + (size_t)nxt.pm * tstep : cA; const char* nB = has_next ? (const char*)g.Bt + (size_t)nxt.pn * tstep : cB;
        for (int t = 0; t < nt; t += 2) {
            const bool last = (t == nt - 2);
            const char* a1 = cA + (size_t)(t + 1) * kstep;
            const char* a2 = last ? nA : cA + (size_t)(t + 2) * kstep; const char* b2 = last ? nB : cB + (size_t)(t + 2) * kstep;
            const char* a3 = a2 + kstep; const char* b3 = b2 + kstep;
            if (last && has_next) S.a_ready(nxt);
            PG8_LDB(B0, 0, 0); PG8_SCHED; PG8_LDA(At, 0, 0); PG8_STAGE(PG8_SA(1, 1), a1 + hstep, voffA);
            PG8_WAIT_L(8); PG8_BAR; PG8_WAIT_L(0); PG8_MMA(0, 0, At, B0); PG8_BAR; PG8_SCHED;
            PG8_LDB(B1, 0, 1); PG8_STAGE(PG8_SB(0, 0), b2, voffB);
            PG8_BAR; PG8_WAIT_L(0); PG8_MMA(0, 1, At, B1); PG8_BAR;
            PG8_LDA(At, 0, 1); PG8_STAGE(PG8_SA(0, 0), a2, voffA);
            PG8_BAR; PG8_WAIT_L(0); PG8_MMA(1, 0, At, B0); PG8_BAR; PG8_SCHED;
            PG8_STAGE(PG8_SB(0, 1), b2 + hstep, voffB);
            PG8_WAIT_V(6); PG8_BAR; PG8_MMA(1, 1, At, B1); PG8_BAR;
            PG8_LDB(B0, 1, 0); PG8_SCHED; PG8_LDA(At, 1, 0); PG8_STAGE(PG8_SA(0, 1), a2 + hstep, voffA);
            PG8_WAIT_L(8); PG8_BAR; PG8_WAIT_L(0); PG8_MMA(0, 0, At, B0); PG8_BAR; PG8_SCHED;
            PG8_LDB(B1, 1, 1); PG8_STAGE(PG8_SB(1, 0), b3, voffB);
            PG8_BAR; PG8_WAIT_L(0); PG8_MMA(0, 1, At, B1); PG8_BAR;
            PG8_LDA(At, 1, 1); PG8_STAGE(PG8_SA(1, 0), a3, voffA);
            PG8_BAR; PG8_WAIT_L(0); PG8_MMA(1, 0, At, B0); PG8_BAR; PG8_SCHED;
            PG8_STAGE(PG8_SB(1, 1), b3 + hstep, voffB);
            PG8_WAIT_V(6); PG8_BAR; PG8_MMA(1, 1, At, B1); PG8_BAR;
        }
        PG8_STAMP();
        if constexpr (!Epi::AFTER_DRAIN) { E(acc, cur, wr, wc, fr, fq); S.done(cur); }
        PG8_STAMP();
        if (!has_next) break;
#pragma unroll
        for (int a = 0; a < 2; ++a)
#pragma unroll
            for (int b = 0; b < 2; ++b)
#pragma unroll
                for (int m = 0; m < 4; ++m)
#pragma unroll
                    for (int n = 0; n < 2; ++n) acc[a][b][m][n] = (f32x4){0.f, 0.f, 0.f, 0.f};
        cur = nxt; cA = nA; cB = nB; ++ui;
    }
    PG8_WAIT_V(0);
    if (wr == 0) PG8_BAR;
    PG8_BAR;
    if constexpr (Epi::AFTER_DRAIN) { E.fused(acc, cur, wr, wc, fr, fq, lds, wid, lane); S.done(cur); }
    PG8_STAMP();
    if (STAMP && wid == 0) { stamps[lane] = lane < nts ? (((unsigned long long)(unsigned)ts_hi << 32) | (unsigned)ts_lo) : 0ull;
        if (lane == 62) stamps[62] = rt_entry; if (lane == 63) stamps[63] = (unsigned long long)wall_clock64(); }
#undef PG8_STAMP
#undef PG8_SA
#undef PG8_SB
#undef PG8_STAGE
#undef PG8_LDA
#undef PG8_LDB
#undef PG8_MMA
#undef PG8_WAIT_V
#undef PG8_WAIT_L
#undef PG8_BAR
#undef PG8_SCHED
}
}

__device__ __forceinline__ void phase_inproj(const Params& p, char* smem, int cwg) {
    pg8::Gemm g; g.A = (const pg8::bf16_t*)p.xh; g.Bt = (const pg8::bf16_t*)p.WinT; g.M = T_; g.N = NINP; g.K = D_;
    pg8::StaticOrder so; so.init(T_, NINP, gridDim.x, cwg);
    pg8::EpiRowScaleF16 e; e.O = p.P; e.ldc = NINP; e.rowscale = p.rstd1;
    pg8::gemm_phase<pg8::EpiRowScaleF16, pg8::StaticOrder, false>((PG8_LAS unsigned char*)smem, g, so, e, nullptr);
}

__device__ __forceinline__ float ps_val(const f16* P, const float* mu, int t, int c) {
    const float cur = (float)P[(size_t)t * NINP + c];
    const float prv = t > 0 ? (float)P[(size_t)(t - 1) * NINP + c] : 0.f;
    return cur + (prv - cur) * mu[c];
}
#define RP_TD 0
#define RP_AD 18432
#define RP_SG 36864
#define RP_SGS 336
__device__ __forceinline__ float half_sum32(float v) {
    v += __shfl_xor(v, 1); v += __shfl_xor(v, 2); v += __shfl_xor(v, 4); v += __shfl_xor(v, 8); v += __shfl_xor(v, 16);
    return v;
}
#define RP2_TD 0
#define RP2_AD 4608
#define RP2_SG 9216
#define RP2_PS 20480
#define RP2_PSB 12672
__device__ __forceinline__ float fast_sigmoid(float v) { return __builtin_amdgcn_rcpf(1.0f + __expf(-v)); }
__device__ __forceinline__ void phase_rwkvprep(const Params& p, char* smem) {
    const int tid0 = phase_tid();
    for (int u = blockIdx.x; u < T_ / 32; u += gridDim.x) {
        int tid = tid0; asm volatile("" : "+v"(tid));
        const int lane = tid & 63, wid = tid >> 6, r = lane & 31, h = lane >> 5;
        const int t0 = u * 32;
        __syncthreads();
#pragma unroll
        for (int rr = 0; rr < 4; ++rr) {
            const int tl = wid * 4 + rr, t = t0 + tl;
#pragma unroll
            for (int q = 0; q < 5; ++q) {
                const int c = lane + 64 * q;
                if (c < 288) {
                    const float v = ps_val(p.P, p.mu, t, C_WD + c);
                    if (q == 0) *(f16*)(smem + RP2_TD + tl * 144 + c * 2) = (f16)(2.0f * fast_sigmoid(2.0f * v) - 1.0f);
                    else if (q == 1) *(f16*)(smem + RP2_AD + tl * 144 + (c - 64) * 2) = (f16)v;
                    else *(f16*)(smem + RP2_SG + tl * RP_SGS + (c - 128) * 2) = (f16)fast_sigmoid(v);
                }
            }
        }
        __syncthreads();
#define RP_ROW(i) ((i & 3) + 8 * (i >> 2))
        for (int hh = 0; hh < 2; ++hh) {
            const int hd = wid * 2 + hh;
            {
                f32x16 ag_[2];
#pragma unroll
                for (int j = 0; j < 2; ++j)
#pragma unroll
                    for (int i = 0; i < 16; ++i) ag_[j][i] = 0.f;
#pragma unroll
                for (int s = 0; s < 10; ++s) {
                    const half8 fg = *(const half8*)(smem + RP2_SG + r * RP_SGS + (16 * s + 8 * h) * 2);
#pragma unroll
                    for (int j = 0; j < 2; ++j) {
                        const int ch = hd * 64 + 32 * j + r;
                        ag_[j] = __builtin_amdgcn_mfma_f32_32x32x16_f16(fg, *(const half8*)(p.WguT + ((size_t)((hd * 2 + j) * 10 + s) * 64 + lane) * 8), ag_[j], 0, 0, 0);
                    }
                }
#pragma unroll
                for (int j = 0; j < 2; ++j) {
                    f16* Gb = p.G + (size_t)(t0 + 4 * h) * RW + hd * 64 + 32 * j + r;
                    asm volatile("" : "+v"(Gb));
#pragma unroll
                    for (int i = 0; i < 16; ++i) Gb[(size_t)RP_ROW(i) * RW] = (f16)ag_[j][i];
                }
            }
            asm volatile("" ::: "memory");
            {
                char* Lp = smem + RP2_PS + wid * RP2_PSB;
#pragma unroll
                for (int i = 0; i < 13; ++i) {
                    const int c = lane + 64 * i;
                    if (c < 33 * 24) {
                        const int row = c / 24, rem = c - row * 24, arr = rem >> 3, cc = rem & 7;
                        const int t = t0 - 1 + row;
                        u32x4 v = {0u, 0u, 0u, 0u};
                        if (t >= 0) v = *(const u32x4*)(p.P + (size_t)t * NINP + arr * 1024 + hd * 64 + cc * 8);
                        *(u32x4*)(Lp + row * 384 + arr * 128 + cc * 16) = v;
                    }
                }
            }
            WAVE_LDS_SYNC();
            const char* Lq = smem + RP2_PS + wid * RP2_PSB + 4 * h * 384;
            float kinv[16];
#pragma unroll
            for (int i = 0; i < 16; ++i) kinv[i] = 0.f;
#pragma unroll
            for (int j = 0; j < 2; ++j) {
                const int ch = hd * 64 + 32 * j + r;
                const float mk = p.mu[C_K + ch], kkw = p.k_k[ch];
#pragma unroll
                for (int i = 0; i < 16; ++i) {
                    const char* q = Lq + RP_ROW(i) * 384 + 128 + (32 * j + r) * 2;
                    const float p_ = (float)*(const f16*)q, c_ = (float)*(const f16*)(q + 384);
                    const float kk = (c_ + (p_ - c_) * mk) * kkw;
                    kinv[i] += kk * kk;
                }
            }
#pragma unroll
            for (int i = 0; i < 16; ++i) kinv[i] = 1.0f / fmaxf(sqrtf(half_sum32(kinv[i])), 1e-12f);
            float bs[16];
#pragma unroll
            for (int i = 0; i < 16; ++i) bs[i] = 0.f;
#pragma unroll
            for (int j = 0; j < 2; ++j) {
                const int ch = hd * 64 + 32 * j + r;
                const float mr = p.mu[C_R + ch], mk = p.mu[C_K + ch], mv = p.mu[C_V + ch];
                const float kkw = p.k_k[ch], kaw = p.k_a[ch], rkw = p.r_k[ch], wd0 = p.w_decay0[ch], a0v = p.a0[ch];
                f32x16 adj, aaj;
#pragma unroll
                for (int i = 0; i < 16; ++i) { adj[i] = 0.f; aaj[i] = 0.f; }
#pragma unroll
                for (int s = 0; s < 4; ++s) {
                    const half8 fa = *(const half8*)(smem + RP2_TD + r * 144 + (16 * s + 8 * h) * 2);
                    const half8 fb = *(const half8*)(smem + RP2_AD + r * 144 + (16 * s + 8 * h) * 2);
                    adj = __builtin_amdgcn_mfma_f32_32x32x16_f16(fa, *(const half8*)(p.WduT + ((size_t)((hd * 2 + j) * 4 + s) * 64 + lane) * 8), adj, 0, 0, 0);
                    aaj = __builtin_amdgcn_mfma_f32_32x32x16_f16(fb, *(const half8*)(p.WauT + ((size_t)((hd * 2 + j) * 4 + s) * 64 + lane) * 8), aaj, 0, 0, 0);
                }
                size_t ob = ((size_t)(hd * (T_ / 16) + (t0 >> 4)) * 64 + 32 * j + r) * 16 + 4 * h;
                asm volatile("" : "+v"(ob));
#pragma unroll
                for (int ig = 0; ig < 4; ++ig) {
                    half4 r4, k4, v4, a4, b4; f32x4 w4;
#pragma unroll
                    for (int e = 0; e < 4; ++e) {
                        const int i = 4 * ig + e;
                        const char* q = Lq + RP_ROW(i) * 384 + (32 * j + r) * 2;
                        const float rp = (float)*(const f16*)q, kp = (float)*(const f16*)(q + 128), vp = (float)*(const f16*)(q + 256);
                        const float rc = (float)*(const f16*)(q + 384), kc = (float)*(const f16*)(q + 512), vc = (float)*(const f16*)(q + 640);
                        const float rr = rc + (rp - rc) * mr, k = kc + (kp - kc) * mk, v = vc + (vp - vc) * mv;
                        const float a = fast_sigmoid(a0v + aaj[i]);
                        const float lw = -0.60653066f * fast_sigmoid(wd0 + adj[i]);
                        const float kk = k * kkw * kinv[i];
                        const float k2 = k * (1.0f + (a - 1.0f) * kaw);
                        bs[i] += rr * k2 * rkw;
                        r4[e] = (f16)rr; k4[e] = (f16)k2; v4[e] = (f16)v; a4[e] = (f16)(-kk); b4[e] = (f16)(kk * a); w4[e] = lw;
                    }
                    const size_t o = ob + (size_t)(ig >> 1) * 1024 + (ig & 1) * 8;
                    *(half4*)(p.R + o) = r4; *(half4*)(p.K2 + o) = k4; *(half4*)(p.V + o) = v4; *(half4*)(p.A + o) = a4; *(half4*)(p.B + o) = b4;
                    *(f32x4*)(p.Wd + o) = w4;
                }
            }
            WAVE_LDS_SYNC();
#pragma unroll
            for (int i = 0; i < 16; ++i) {
                const float b = half_sum32(bs[i]);
                if (r == 0) p.bonus[(t0 + RP_ROW(i) + 4 * h) * NH + hd] = b;
            }
        }
#undef RP_ROW
    }
}

__device__ __forceinline__ void phase_rope(const Params& p, char* smem) {
    const int tid = phase_tid(), lane = tid & 63, wid = tid >> 6;
    for (int t = blockIdx.x * 8 + wid; t < T_; t += gridDim.x * 8) {
        for (int i = lane; i < 640; i += 64) {
            const int hd = i >> 5, j = i & 31;
            const float cs = p.ropec[t * 32 + j], sn = p.ropes[t * 32 + j];
            if (hd < 16) {
                const float x1 = (float)p.P[(size_t)t * NINP + C_AQ + hd * 64 + j], x2 = (float)p.P[(size_t)t * NINP + C_AQ + hd * 64 + 32 + j];
                p.qr[(size_t)t * 1024 + hd * 64 + j] = (f16)((x1 * cs - x2 * sn) * 0.125f);
                p.qr[(size_t)t * 1024 + hd * 64 + 32 + j] = (f16)((x2 * cs + x1 * sn) * 0.125f);
            } else {
                const int kh = hd - 16;
                const float x1 = (float)p.P[(size_t)t * NINP + C_AK + kh * 64 + j], x2 = (float)p.P[(size_t)t * NINP + C_AK + kh * 64 + 32 + j];
                p.kr[(size_t)t * 256 + kh * 64 + j] = (f16)(x1 * cs - x2 * sn);
                p.kr[(size_t)t * 256 + kh * 64 + 32 + j] = (f16)(x2 * cs + x1 * sn);
            }
        }
    }
}

#define SC_AR 0
#define SC_BK 4608
#define SC_AB 4608
#define SC_UB 6656
#define SC_VT 9216
#define SC_BH 11264
#define SC_KH 13312
#define SC_LB 15360
#define SC_LK 16384
#define SC_LAB 17408
#define SC_GAM 18432
#define SC_ERHO 18688
#define SC_S16 18944
#define SC_S16B 28160
#define SC_BYTES 37376
#define NCHK 64
#define CHS 8

__device__ __forceinline__ f32x16 mma16(const char* fa, const char* sb, f32x16 acc) {
    return __builtin_amdgcn_mfma_f32_32x32x16_f16(*(const half8*)fa, *(const half8*)sb, acc, 0, 0, 0);
}

struct ScIn { f32x4 w4[4]; half8 av[2], rv[2], bv[2], kv[2], vv[2]; };
__device__ __forceinline__ void subchunk_load(const Params& p, int hd, int tok0, int lane, ScIn& in) {
    const size_t o = ((size_t)(hd * (T_ / 16) + (tok0 >> 4)) * 64 + lane) * 16;
#pragma unroll
    for (int q = 0; q < 4; ++q) in.w4[q] = *(const f32x4*)(p.Wd + o + 4 * q);
#pragma unroll
    for (int q = 0; q < 2; ++q) {
        in.av[q] = *(const half8*)(p.A + o + 8 * q); in.rv[q] = *(const half8*)(p.R + o + 8 * q); in.bv[q] = *(const half8*)(p.B + o + 8 * q);
        in.kv[q] = *(const half8*)(p.K2 + o + 8 * q); in.vv[q] = *(const half8*)(p.V + o + 8 * q);
    }
}
__device__ __forceinline__ void subchunk_compute(const ScIn& in, char* L, int lane, f32x16 (&d6)[2], const Params& p, int hd, int tokn, ScIn& nxt) {
    const int r = lane & 31, h = lane >> 5;
    float xa[16];
    {
        const f32x4 (&w4)[4] = in.w4; const half8 (&av)[2] = in.av, (&rv)[2] = in.rv, (&bv)[2] = in.bv, (&kv)[2] = in.kv, (&vv)[2] = in.vv;
        float g[16];
        float acc = 0.f;
#pragma unroll
        for (int t = 0; t < 16; ++t) { acc += w4[t >> 2][t & 3]; g[t] = acc * 1.4426950408889634f; }
        const float rho = g[7], gC = g[15];
        const float ec = __builtin_amdgcn_exp2f(gC - rho);
        float erp = __builtin_amdgcn_exp2f(-rho);
#pragma unroll
        for (int tb = 0; tb < 2; ++tb) {
            half8 bh, kh, vt8;
#pragma unroll
            for (int tt = 0; tt < 8; ++tt) {
                const int t = tb * 8 + tt;
                const float ea = erp, er = __builtin_amdgcn_exp2f(g[t] - rho), eb = __builtin_amdgcn_exp2f(rho - g[t]), eh = eb * ec;
                erp = er;
                const float a_ = (float)av[tb][tt], r_ = (float)rv[tb][tt], b_ = (float)bv[tb][tt], k_ = (float)kv[tb][tt], v_ = (float)vv[tb][tt];
                xa[t] = a_ * ea;
                *(f16*)(L + SC_AR + t * 144 + lane * 2) = (f16)xa[t];
                *(f16*)(L + SC_AR + (16 + t) * 144 + lane * 2) = (f16)(r_ * er);
                *(f16*)(L + SC_BK + t * 144 + lane * 2) = (f16)(b_ * eb);
                *(f16*)(L + SC_BK + (16 + t) * 144 + lane * 2) = (f16)(k_ * eb);
                bh[tt] = (f16)(b_ * eh); kh[tt] = (f16)(k_ * eh); vt8[tt] = (f16)v_;
            }
            *(half8*)(L + SC_BH + lane * 32 + tb * 16) = bh;
            *(half8*)(L + SC_KH + lane * 32 + tb * 16) = kh;
            *(half8*)(L + SC_VT + lane * 32 + tb * 16) = vt8;
        }
        *(float*)(L + SC_GAM + lane * 4) = __builtin_amdgcn_exp2f(gC);
        *(float*)(L + SC_ERHO + lane * 4) = __builtin_amdgcn_exp2f(rho);
    }
    WAVE_LDS_SYNC();
    {
        f32x16 g1;
#pragma unroll
        for (int i = 0; i < 16; ++i) g1[i] = 0.f;
#pragma unroll
        for (int s = 0; s < 4; ++s) g1 = mma16(L + SC_AR + r * 144 + (16 * s + 8 * h) * 2, L + SC_BK + r * 144 + (16 * s + 8 * h) * 2, g1);
        const int col = r, ii = col & 15;
#pragma unroll
        for (int i = 0; i < 16; ++i) {
            const int row = (i & 3) + 8 * (i >> 2) + 4 * h, tt = row & 15;
            const bool keep = (row >= 16) ? (ii <= tt) : (ii < tt);
            const float val = keep ? g1[i] : 0.f;
            if (col < 16) {
                *(f16*)(L + SC_LB + row * 32 + col * 2) = (f16)val;
                if (row < 16) *(float*)(L + SC_LAB + (row * 16 + col) * 4) = val;
            } else {
                *(f16*)(L + SC_LK + row * 32 + (col - 16) * 2) = (f16)val;
            }
        }
    }
    WAVE_LDS_SYNC();
#pragma unroll
    for (int vt = 0; vt < 2; ++vt) {
#pragma unroll
        for (int i = 0; i < 16; ++i) d6[vt][i] = 0.f;
        d6[vt] = mma16(L + SC_VT + (32 * vt + r) * 32 + h * 16, L + SC_LK + r * 32 + h * 16, d6[vt]);
        if (r < 16) {
#pragma unroll
            for (int g = 0; g < 4; ++g) {
                f32x4 w4; w4[0] = d6[vt][4 * g]; w4[1] = d6[vt][4 * g + 1]; w4[2] = d6[vt][4 * g + 2]; w4[3] = d6[vt][4 * g + 3];
                *(f32x4*)(L + SC_BK + (r * 64 + 32 * vt + 8 * g + 4 * h) * 4) = w4;
            }
        }
    }
    WAVE_LDS_SYNC();
    {
        float xu[16];
#pragma unroll
        for (int t = 0; t < 16; ++t) xu[t] = *(const float*)(L + SC_BK + (t * 64 + lane) * 4);
#pragma unroll
        for (int t = 1; t < 16; ++t) {
            float lrow[16];
            if ((t & 3) == 0) asm volatile("" ::: "memory");
#pragma unroll
            for (int q = 0; q < 4; ++q) { const f32x4 l4 = *(const f32x4*)(L + SC_LAB + (t * 16 + 4 * q) * 4); lrow[4 * q] = l4[0]; lrow[4 * q + 1] = l4[1]; lrow[4 * q + 2] = l4[2]; lrow[4 * q + 3] = l4[3]; }
#pragma unroll
            for (int i = 0; i < t; ++i) { xa[t] = fmaf(lrow[i], xa[i], xa[t]); xu[t] = fmaf(lrow[i], xu[i], xu[t]); }
        }
        const float erho = *(const float*)(L + SC_ERHO + lane * 4);
        half8 a0, a1, u0, u1;
#pragma unroll
        for (int t = 0; t < 8; ++t) { a0[t] = (f16)xa[t]; a1[t] = (f16)xa[t + 8]; u0[t] = (f16)xu[t]; u1[t] = (f16)xu[t + 8]; }
        *(half8*)(L + SC_AB + lane * 32) = a0; *(half8*)(L + SC_AB + lane * 32 + 16) = a1;
        *(half8*)(L + SC_UB + lane * 32) = u0; *(half8*)(L + SC_UB + lane * 32 + 16) = u1;
#pragma unroll
        for (int t = 0; t < 16; ++t) *(f16*)(L + SC_AR + t * 144 + lane * 2) = (f16)(xa[t] * erho);
    }
    WAVE_LDS_SYNC();
    subchunk_load(p, hd, tokn, lane, nxt);
#pragma unroll
    for (int kt = 0; kt < 2; ++kt) {
        f32x16 d5;
#pragma unroll
        for (int i = 0; i < 16; ++i) d5[i] = 0.f;
        d5 = mma16(L + SC_AB + (32 * kt + r) * 32 + h * 16, L + SC_LB + r * 32 + h * 16, d5);
        if (r >= 16) {
#pragma unroll
            for (int g = 0; g < 4; ++g) {
                const int k0 = 32 * kt + 8 * g + 4 * h;
                char* ap = L + SC_AR + r * 144 + k0 * 2;
                const half4 rv = *(const half4*)ap;
                const f32x4 e4 = *(const f32x4*)(L + SC_ERHO + k0 * 4);
                half4 o;
#pragma unroll
                for (int e = 0; e < 4; ++e) o[e] = (f16)(((float)rv[e] + d5[4 * g + e]) * e4[e]);
                *(half4*)ap = o;
            }
        }
    }
#pragma unroll
    for (int vt = 0; vt < 2; ++vt) d6[vt] = mma16(L + SC_UB + (32 * vt + r) * 32 + h * 16, L + SC_LB + r * 32 + h * 16, d6[vt]);
    WAVE_LDS_SYNC();
}

template <bool WITH_IN>
__device__ __forceinline__ void subchunk_apply(char* L, const f32x16 (&d6)[2], f32x16 (&duy)[2], int lane, int sofs = SC_S16) {
    const int r = lane & 31, h = lane >> 5;
#pragma unroll
    for (int vt = 0; vt < 2; ++vt) {
        if (WITH_IN) duy[vt] = d6[vt];
        else {
#pragma unroll
            for (int i = 0; i < 16; ++i) duy[vt][i] = 0.f;
        }
#pragma unroll
        for (int s = 0; s < 4; ++s) duy[vt] = mma16(L + sofs + (32 * vt + r) * 144 + (16 * s + 8 * h) * 2, L + SC_AR + r * 144 + (16 * s + 8 * h) * 2, duy[vt]);
        if (r < 16) {
#pragma unroll
            for (int i = 0; i < 16; ++i) {
                const int v = 32 * vt + (i & 3) + 8 * (i >> 2) + 4 * h;
                *(f16*)(L + SC_UB + v * 32 + r * 2) = (f16)duy[vt][i];
            }
        }
    }
    WAVE_LDS_SYNC();
#pragma unroll
    for (int kt = 0; kt < 2; ++kt)
#pragma unroll
        for (int vt = 0; vt < 2; ++vt) {
            f32x16 acc;
            char* sp = L + sofs + (32 * vt + r) * 144 + (32 * kt + 4 * h) * 2;
#pragma unroll
            for (int g = 0; g < 4; ++g) {
                const f32x4 gm = *(const f32x4*)(L + SC_GAM + (32 * kt + 8 * g + 4 * h) * 4);
                const half4 sv = *(const half4*)(sp + 16 * g);
#pragma unroll
                for (int e = 0; e < 4; ++e) acc[4 * g + e] = (float)sv[e] * gm[e];
            }
            acc = mma16(L + SC_BH + (32 * kt + r) * 32 + h * 16, L + SC_UB + (32 * vt + r) * 32 + h * 16, acc);
            if (WITH_IN) acc = mma16(L + SC_KH + (32 * kt + r) * 32 + h * 16, L + SC_VT + (32 * vt + r) * 32 + h * 16, acc);
#pragma unroll
            for (int g = 0; g < 4; ++g) {
                half4 o;
#pragma unroll
                for (int e = 0; e < 4; ++e) o[e] = (f16)acc[4 * g + e];
                *(half4*)(sp + 16 * g) = o;
            }
        }
    WAVE_LDS_SYNC();
}

__device__ __forceinline__ void side_cvt_wdn(const Params& p, int sw, int nsw, int lane, size_t q0, size_t q1) {
    const size_t stride = (size_t)nsw * 64;
    size_t i = q0 + (size_t)sw * 64 + lane;
    for (; i + 7 * stride < q1; i += 8 * stride) {
        f32x4 v[8];
#pragma unroll
        for (int j = 0; j < 8; ++j) v[j] = __builtin_nontemporal_load((const f32x4*)p.w_dn + i + j * stride);
#pragma unroll
        for (int j = 0; j < 8; ++j) { half4 o; o[0] = (f16)v[j][0]; o[1] = (f16)v[j][1]; o[2] = (f16)v[j][2]; o[3] = (f16)v[j][3]; *((half4*)p.Wdn16 + i + j * stride) = o; }
    }
    for (; i < q1; i += stride) {
        const f32x4 v = __builtin_nontemporal_load((const f32x4*)p.w_dn + i);
        half4 o; o[0] = (f16)v[0]; o[1] = (f16)v[1]; o[2] = (f16)v[2]; o[3] = (f16)v[3]; *((half4*)p.Wdn16 + i) = o;
    }
}
__device__ __forceinline__ void side_rope(const Params& p, int sw, int nsw, int lane) {
    for (int t = sw; t < T_; t += nsw) {
        for (int i = lane; i < 640; i += 64) {
            const int hd = i >> 5, j = i & 31;
            const float cs = p.ropec[t * 32 + j], sn = p.ropes[t * 32 + j];
            if (hd < 16) {
                const float x1 = (float)p.P[(size_t)t * NINP + C_AQ + hd * 64 + j], x2 = (float)p.P[(size_t)t * NINP + C_AQ + hd * 64 + 32 + j];
                p.qr[(size_t)t * 1024 + hd * 64 + j] = (f16)((x1 * cs - x2 * sn) * 0.125f);
                p.qr[(size_t)t * 1024 + hd * 64 + 32 + j] = (f16)((x2 * cs + x1 * sn) * 0.125f);
            } else {
                const int kh = hd - 16;
                const float x1 = (float)p.P[(size_t)t * NINP + C_AK + kh * 64 + j], x2 = (float)p.P[(size_t)t * NINP + C_AK + kh * 64 + 32 + j];
                p.kr[(size_t)t * 256 + kh * 64 + j] = (f16)(x1 * cs - x2 * sn);
                p.kr[(size_t)t * 256 + kh * 64 + 32 + j] = (f16)(x2 * cs + x1 * sn);
            }
        }
    }
}
#define WDN_Q4 ((size_t)NEXP * DE * D_ / 4)
#define WDN_SPLIT (WDN_Q4 * 3 / 5)

__device__ __forceinline__ void phase_rwkv1(const Params& p, char* smem) {
    const int tid = phase_tid(), lane = tid & 63, wid = tid >> 6;
    if (wid >= 4) { const int sw = blockIdx.x * 4 + (wid - 4), nsw = gridDim.x * 4; side_rope(p, sw, nsw, lane); return; }
    char* L = smem + wid * SC_BYTES;
    for (int unit = blockIdx.x * 4 + wid; unit < NH * NCHK; unit += gridDim.x * 4) {
        const int hd = unit / NCHK, c = unit % NCHK;
        {
            const half8 z = {0, 0, 0, 0, 0, 0, 0, 0};
#pragma unroll
            for (int q = 0; q < 8; ++q) { *(half8*)(L + SC_S16 + lane * 144 + q * 16) = z; *(half8*)(L + SC_S16B + lane * 144 + q * 16) = z; }
            *(f16*)(L + SC_S16B + lane * 144 + lane * 2) = (f16)1.f;
        }
        WAVE_LDS_SYNC();
        ScIn cur; subchunk_load(p, hd, c * CHS * 16, lane, cur);
        for (int s = 0; s < CHS; ++s) {
            f32x16 d6[2], duy[2];
            ScIn nxt;
            subchunk_compute(cur, L, lane, d6, p, hd, (c * CHS + (s + 1 < CHS ? s + 1 : s)) * 16, nxt);
            subchunk_apply<true>(L, d6, duy, lane, SC_S16);
            subchunk_apply<false>(L, d6, duy, lane, SC_S16B);
            cur = nxt;
        }
        const size_t base = (size_t)(hd * NCHK + c) * 4096;
#pragma unroll
        for (int q = 0; q < 8; ++q) *(half8*)(p.segQ + base + lane * 64 + q * 8) = *(const half8*)(L + SC_S16 + lane * 144 + q * 16);
#pragma unroll 8
        for (int k = 0; k < 64; ++k) p.PT[base + k * 64 + lane] = *(const f16*)(L + SC_S16B + lane * 144 + k * 2);
        WAVE_LDS_SYNC();
    }
}

#define PF2 8
#define R2_SLOT 27648
__device__ __forceinline__ void phase_rwkv2_head(const Params& p, char* smem, int hd) {
    const int tid = phase_tid(), lane = tid & 63, r = lane & 31, h = lane >> 5;
    const int wid = __builtin_amdgcn_readfirstlane(tid >> 6);
    const int crow = tid >> 3, cch = tid & 7;
    const int loff = crow * 144 + cch * 16;
    f32x16 acc[2];
#pragma unroll
    for (int kt = 0; kt < 2; ++kt)
#pragma unroll
        for (int i = 0; i < 16; ++i) acc[kt][i] = 0.f;
    u32x4 pn[PF2], qn[PF2];
    const f16* PTh = p.PT + (size_t)hd * NCHK * 4096 + crow * 64 + cch * 8;
    const f16* Qh = p.segQ + (size_t)hd * NCHK * 4096 + crow * 64 + cch * 8;
    f16* Sh = p.Sst + (size_t)hd * NCHK * 4096 + crow * 64 + cch * 8;
#pragma unroll
    for (int j = 0; j < PF2; ++j) { pn[j] = *(const u32x4*)(PTh + (size_t)j * 4096); qn[j] = *(const u32x4*)(Qh + (size_t)j * 4096); }
    __syncthreads();
#pragma unroll
    for (int j = 0; j < 2; ++j) {
        *(u32x4*)(smem + j * R2_SLOT + loff) = pn[j]; *(u32x4*)(smem + j * R2_SLOT + 9216 + loff) = qn[j];
        pn[j] = *(const u32x4*)(PTh + (size_t)(PF2 + j) * 4096); qn[j] = *(const u32x4*)(Qh + (size_t)(PF2 + j) * 4096);
    }
    asm volatile("s_waitcnt lgkmcnt(0)" ::: "memory");
    __builtin_amdgcn_s_barrier();
    asm volatile("" ::: "memory");
    for (int c0 = 0; c0 < NCHK; c0 += PF2) {
#pragma unroll
        for (int j = 0; j < PF2; ++j) {
            const int c = c0 + j, jj = (j + 2) & (PF2 - 1);
            if (wid < 2) {
                const char* Sl = smem + (j & 3) * R2_SLOT;
                half4 pf[2][4][2];
#pragma unroll
                for (int kt = 0; kt < 2; ++kt)
#pragma unroll
                    for (int ks = 0; ks < 4; ++ks) {
                        pf[kt][ks][0] = *(const half4*)(Sl + (32 * kt + r) * 144 + (16 * ks + 4 * h) * 2);
                        pf[kt][ks][1] = *(const half4*)(Sl + (32 * kt + r) * 144 + (16 * ks + 8 + 4 * h) * 2);
                    }
                f32x16 an[2];
#pragma unroll
                for (int kt = 0; kt < 2; ++kt)
#pragma unroll
                    for (int g = 0; g < 4; ++g) {
                        const half4 qv = *(const half4*)(Sl + 9216 + (32 * wid + r) * 144 + (32 * kt + 8 * g + 4 * h) * 2);
                        an[kt][4 * g] = (float)qv[0]; an[kt][4 * g + 1] = (float)qv[1]; an[kt][4 * g + 2] = (float)qv[2]; an[kt][4 * g + 3] = (float)qv[3];
                    }
                half8 sf[4];
#pragma unroll
                for (int ks = 0; ks < 4; ++ks)
#pragma unroll
                    for (int e = 0; e < 8; ++e) sf[ks][e] = (f16)acc[ks >> 1][8 * (ks & 1) + e];
#pragma unroll
                for (int ks = 0; ks < 4; ++ks) {
                    half4 lo, hi;
#pragma unroll
                    for (int e = 0; e < 4; ++e) { lo[e] = sf[ks][e]; hi[e] = sf[ks][4 + e]; }
                    *(half4*)(const_cast<char*>(Sl) + 18432 + (32 * wid + r) * 144 + (16 * ks + 4 * h) * 2) = lo;
                    *(half4*)(const_cast<char*>(Sl) + 18432 + (32 * wid + r) * 144 + (16 * ks + 8 + 4 * h) * 2) = hi;
                }
#pragma unroll
                for (int ks = 0; ks < 4; ++ks)
#pragma unroll
                    for (int kt = 0; kt < 2; ++kt) {
                        half8 af;
#pragma unroll
                        for (int e = 0; e < 4; ++e) { af[e] = pf[kt][ks][0][e]; af[4 + e] = pf[kt][ks][1][e]; }
                        an[kt] = __builtin_amdgcn_mfma_f32_32x32x16_f16(af, sf[ks], an[kt], 0, 0, 0);
                    }
                acc[0] = an[0]; acc[1] = an[1];
            }
            {
                char* Sw = smem + ((j + 2) & 3) * R2_SLOT;
                *(u32x4*)(Sw + loff) = pn[jj]; *(u32x4*)(Sw + 9216 + loff) = qn[jj];
                const int cn = (c + 2 + PF2 < NCHK) ? (c + 2 + PF2) : (NCHK - 1);
                pn[jj] = *(const u32x4*)(PTh + (size_t)cn * 4096); qn[jj] = *(const u32x4*)(Qh + (size_t)cn * 4096);
            }
            {
                const int cm = c > 0 ? c - 1 : 0;
                *(u32x4*)(Sh + (size_t)cm * 4096) = *(const u32x4*)(smem + ((j + 3) & 3) * R2_SLOT + 18432 + loff);
            }
            asm volatile("s_waitcnt lgkmcnt(0)" ::: "memory");
            __builtin_amdgcn_s_barrier();
            asm volatile("" ::: "memory");
        }
    }
    *(u32x4*)(Sh + (size_t)(NCHK - 1) * 4096) = *(const u32x4*)(smem + ((NCHK - 1) & 3) * R2_SLOT + 18432 + loff);
}

__device__ __forceinline__ void phase_rwkv3(const Params& p, char* smem) {
    const int tid = phase_tid(), lane = tid & 63, wid = tid >> 6, r = lane & 31, h = lane >> 5;
    if (wid >= 4) return;
    char* L = smem + wid * SC_BYTES;
    for (int unit = blockIdx.x * 4 + wid; unit < NH * NCHK; unit += gridDim.x * 4) {
        const int hd = unit / NCHK, c = unit % NCHK;
        const size_t base = (size_t)(hd * NCHK + c) * 4096;
#pragma unroll
        for (int q = 0; q < 8; ++q) *(half8*)(L + SC_S16 + lane * 144 + q * 16) = *(const half8*)(p.Sst + base + lane * 64 + q * 8);
        WAVE_LDS_SYNC();
        ((float*)(L + SC_S16B))[lane] = p.gn_w[hd * 64 + lane]; ((float*)(L + SC_S16B))[64 + lane] = p.gn_b[hd * 64 + lane];
        ScIn cur; subchunk_load(p, hd, c * CHS * 16, lane, cur);
        for (int s = 0; s < CHS; ++s) {
            f32x16 d6[2], duy[2];
            const int tok0 = (c * CHS + s) * 16;
            ScIn nxt;
            const int te = tok0 + (r >= 16 ? r - 16 : 0);
            half4 ggv[2][4];
#pragma unroll
            for (int vt = 0; vt < 2; ++vt)
#pragma unroll
                for (int g = 0; g < 4; ++g) ggv[vt][g] = *(const half4*)(p.G + (size_t)te * RW + hd * 64 + 32 * vt + 8 * g + 4 * h);
            const float bon = p.bonus[te * NH + hd];
            subchunk_compute(cur, L, lane, d6, p, hd, (c * CHS + (s + 1 < CHS ? s + 1 : s)) * 16, nxt);
            subchunk_apply<true>(L, d6, duy, lane);
            cur = nxt;
            float sum = 0.f;
#pragma unroll
            for (int vt = 0; vt < 2; ++vt)
#pragma unroll
                for (int i = 0; i < 16; ++i) sum += duy[vt][i];
            sum += __shfl_xor(sum, 32);
            const float mean = sum * (1.0f / 64.0f);
            float sq = 0.f;
#pragma unroll
            for (int vt = 0; vt < 2; ++vt)
#pragma unroll
                for (int i = 0; i < 16; ++i) { const float d = duy[vt][i] - mean; sq += d * d; }
            sq += __shfl_xor(sq, 32);
            const float rstd = 1.0f / sqrtf(sq * (1.0f / 64.0f) + 64e-5f);
            if (r >= 16) {
                const int tl = r - 16, t = tok0 + tl;
#pragma unroll
                for (int vt = 0; vt < 2; ++vt)
#pragma unroll
                    for (int g = 0; g < 4; ++g) {
                        const int v0 = 32 * vt + 8 * g + 4 * h, ch = hd * 64 + v0;
                        const f32x4 gw = *(const f32x4*)(L + SC_S16B + v0 * 4), gb = *(const f32x4*)(L + SC_S16B + 256 + v0 * 4);
                        const half4 gg = ggv[vt][g];
                        half4 o;
#pragma unroll
                        for (int e = 0; e < 4; ++e) {
                            const float vv = (float)*(const f16*)(L + SC_VT + (v0 + e) * 32 + tl * 2);
                            const float yn = (duy[vt][4 * g + e] - mean) * rstd * gw[e] + gb[e] + bon * vv;
                            o[e] = (f16)(yn * (float)gg[e]);
                        }
                        *(half4*)(p.ycat + (size_t)t * D_ + ch) = o;
                    }
            }
        }
    }
}
#define KS_STRIDE 144
#define VT_STRIDE 528
__device__ __forceinline__ void phase_attn(const Params& p, char* smem) {
    const int tid = phase_tid(), lane = tid & 63, wid = tid >> 6, r = lane & 31, h = lane >> 5;
    char* Ks = smem; char* Vt = smem + 256 * KS_STRIDE;
    volatile int* slot = (volatile int*)(smem + 143360);
    for (;;) {
        __syncthreads();
        if (tid == 0) *slot = (int)atomicAdd(&p.bar[10240], 1u);
        __syncthreads();
        const int u = *slot;
        if (u >= 64 * 4) break;
        const int qb = u >> 2, kvh = u & 3, t0 = qb * 128;
        __syncthreads();
#pragma unroll
        for (int i = 0; i < 4; ++i) {
            const int c = tid + NTHR * i, key = c >> 3, cc = c & 7, tk = t0 - 128 + key;
            u32x4 kv = {0u, 0u, 0u, 0u}; half8 vv = {0, 0, 0, 0, 0, 0, 0, 0};
            if (tk >= 0) {
                kv = *(const u32x4*)(p.kr + (size_t)tk * 256 + kvh * 64 + cc * 8);
                vv = *(const half8*)(p.P + (size_t)tk * NINP + C_AV + kvh * 64 + cc * 8);
            }
            *(u32x4*)(Ks + key * KS_STRIDE + cc * 16) = kv;
#pragma unroll
            for (int e = 0; e < 8; ++e) *(f16*)(Vt + (cc * 8 + e) * VT_STRIDE + key * 2) = vv[e];
        }
        __syncthreads();
        const int qh = kvh * 4 + (wid >> 1);
        const float sink = p.sinks[qh];
        for (int sub = 0; sub < 2; ++sub) {
            const int q0 = (wid & 1) * 64 + sub * 32;
            half8 qf[4];
#pragma unroll
            for (int s = 0; s < 4; ++s) qf[s] = *(const half8*)(p.qr + (size_t)(t0 + q0 + r) * 1024 + qh * 64 + 16 * s + 8 * h);
            const int qs = q0 >> 5;
            f32x16 sc[5];
#pragma unroll
            for (int mi = 0; mi < 5; ++mi) {
#pragma unroll
                for (int i = 0; i < 16; ++i) sc[mi][i] = 0.f;
#pragma unroll
                for (int s = 0; s < 4; ++s) {
                    const half8 kf = *(const half8*)(Ks + (32 * (qs + mi) + r) * KS_STRIDE + (16 * s + 8 * h) * 2);
                    sc[mi] = __builtin_amdgcn_mfma_f32_32x32x16_f16(kf, qf[s], sc[mi], 0, 0, 0);
                }
            }
            const int qrel = q0 + r;
            float mx = sink;
#pragma unroll
            for (int mi = 0; mi < 5; ++mi)
#pragma unroll
                for (int i = 0; i < 16; ++i) {
                    const int key = 32 * (qs + mi) + (i & 3) + 8 * (i >> 2) + 4 * h;
                    const int rel = qrel + 128 - key;
                    const bool ok = (rel >= 0) && (rel < 128) && (qb > 0 || key >= 128);
                    sc[mi][i] = ok ? sc[mi][i] : -INFINITY;
                    mx = fmaxf(mx, sc[mi][i]);
                }
            mx = fmaxf(mx, __shfl_xor(mx, 32));
            float den = 0.f;
#pragma unroll
            for (int mi = 0; mi < 5; ++mi)
#pragma unroll
                for (int i = 0; i < 16; ++i) { const float e = __expf(sc[mi][i] - mx); sc[mi][i] = e; den += e; }
            den += __shfl_xor(den, 32);
            den += __expf(sink - mx);
            const float inv = 1.0f / den;
            f32x16 o0, o1;
#pragma unroll
            for (int i = 0; i < 16; ++i) { o0[i] = 0.f; o1[i] = 0.f; }
#pragma unroll
            for (int mi = 0; mi < 5; ++mi)
#pragma unroll
                for (int s = 0; s < 2; ++s) {
                    half8 pf;
#pragma unroll
                    for (int j = 0; j < 8; ++j) pf[j] = (f16)(sc[mi][8 * s + j] * inv);
                    const int kb = 32 * (qs + mi) + 16 * s + 4 * h;
                    half8 v0, v1;
                    {
                        const half4 lo = *(const half4*)(Vt + r * VT_STRIDE + kb * 2), hi = *(const half4*)(Vt + r * VT_STRIDE + (kb + 8) * 2);
                        v0[0] = lo[0]; v0[1] = lo[1]; v0[2] = lo[2]; v0[3] = lo[3]; v0[4] = hi[0]; v0[5] = hi[1]; v0[6] = hi[2]; v0[7] = hi[3];
                    }
                    {
                        const half4 lo = *(const half4*)(Vt + (32 + r) * VT_STRIDE + kb * 2), hi = *(const half4*)(Vt + (32 + r) * VT_STRIDE + (kb + 8) * 2);
                        v1[0] = lo[0]; v1[1] = lo[1]; v1[2] = lo[2]; v1[3] = lo[3]; v1[4] = hi[0]; v1[5] = hi[1]; v1[6] = hi[2]; v1[7] = hi[3];
                    }
                    o0 = __builtin_amdgcn_mfma_f32_32x32x16_f16(v0, pf, o0, 0, 0, 0);
                    o1 = __builtin_amdgcn_mfma_f32_32x32x16_f16(v1, pf, o1, 0, 0, 0);
                }
            f16* orow = p.ycat + (size_t)(t0 + q0 + r) * D_ + RW + qh * 64;
#pragma unroll
            for (int g = 0; g < 4; ++g) {
                half4 a, b;
#pragma unroll
                for (int e = 0; e < 4; ++e) { a[e] = (f16)o0[4 * g + e]; b[e] = (f16)o1[4 * g + e]; }
                *(half4*)(orow + 8 * g + 4 * h) = a;
                *(half4*)(orow + 32 + 8 * g + 4 * h) = b;
            }
        }
    }
}

__device__ __forceinline__ void phase_outproj(const Params& p, char* smem, int cwg) {
    pg8::Gemm g; g.A = (const pg8::bf16_t*)p.ycat; g.Bt = (const pg8::bf16_t*)p.WoutT; g.M = T_; g.N = D_; g.K = D_;
    pg8::StaticOrder so; so.init(T_, D_, gridDim.x, cwg);
    pg8::EpiResidualF32 e; e.C = p.x1; e.base = p.x; e.ldc = D_;
    pg8::gemm_phase<pg8::EpiResidualF32, pg8::StaticOrder, false>((PG8_LAS unsigned char*)smem, g, so, e, nullptr);
}

__device__ __forceinline__ float router_w(const Params& p, int k, int c) {
    if (c < 8) return p.w_rg[k * 8 + c];
    if (c < 72) return p.w_re[k * 64 + (c - 8)];
    return 0.f;
}
__device__ __forceinline__ void phase_router(const Params& p, char* smem) {
    const int tid = phase_tid(), lane = tid & 63, wid = tid >> 6, i32 = lane & 31, kk = lane >> 5;
    float* part = (float*)smem;
    float* ssq = part + 8 * 3 * 16 * 64;
    float* logit = ssq + 2 * NTHR;
    float* rstd_s = logit + 32 * 72;
    for (int u = blockIdx.x; u < T_ / 32; u += gridDim.x) {
        const int t0 = u * 32;
        f32x16 acc[3], acx[3];
#pragma unroll
        for (int j = 0; j < 3; ++j)
#pragma unroll
            for (int i = 0; i < 16; ++i) { acc[j][i] = 0.f; acx[j][i] = 0.f; }
        float ss0 = 0.f, ss1 = 0.f;
        char* XH = smem; char* XL = smem + 8704; char* WH = smem + 17408; char* WL = smem + 17408 + 26112;
        f32x4 xv[2], gv[2]; u32x4 wh[3], wl[3];
#define RT_LOAD(kc) do { _Pragma("unroll") for (int q = 0; q < 2; ++q) { const int idx = tid + NTHR * q, row = idx >> 5, c4 = idx & 31; \
            xv[q] = *(const f32x4*)(p.x1 + (size_t)(t0 + row) * D_ + (kc) + 4 * c4); gv[q] = *(const f32x4*)(p.ln2 + (kc) + 4 * c4); } \
        _Pragma("unroll") for (int q = 0; q < 3; ++q) { const int idx = tid + NTHR * q, row = idx >> 4, cc = idx & 15; \
            wh[q] = *(const u32x4*)(p.WrH + (size_t)row * D_ + (kc) + 8 * cc); wl[q] = *(const u32x4*)(p.WrL + (size_t)row * D_ + (kc) + 8 * cc); } } while (0)
        RT_LOAD(0);
        for (int kc = 0; kc < D_; kc += 128) {
            __syncthreads();
#pragma unroll
            for (int q = 0; q < 2; ++q) {
                const int idx = tid + NTHR * q, row = idx >> 5, c4 = idx & 31;
                half4 hi, lo; float s2 = 0.f;
#pragma unroll
                for (int e = 0; e < 4; ++e) {
                    s2 += xv[q][e] * xv[q][e];
                    const float a_ = xv[q][e] * gv[q][e];
                    hi[e] = (f16)a_; lo[e] = (f16)((a_ - (float)hi[e]) * 2048.0f);
                }
                if (q == 0) ss0 += s2; else ss1 += s2;
                *(half4*)(XH + row * 272 + c4 * 8) = hi; *(half4*)(XL + row * 272 + c4 * 8) = lo;
                *(half4*)(p.xm + (size_t)(t0 + row) * D_ + kc + 4 * c4) = hi;
            }
#pragma unroll
            for (int q = 0; q < 3; ++q) {
                const int idx = tid + NTHR * q, row = idx >> 4, cc = idx & 15;
                *(u32x4*)(WH + row * 272 + cc * 16) = wh[q]; *(u32x4*)(WL + row * 272 + cc * 16) = wl[q];
            }
            __syncthreads();
            if (kc + 128 < D_) RT_LOAD(kc + 128);
            {
                const int ko = (16 * wid + 8 * kk) * 2;
                const half8 ah = *(const half8*)(XH + i32 * 272 + ko), al = *(const half8*)(XL + i32 * 272 + ko);
#pragma unroll
                for (int j = 0; j < 3; ++j) {
                    const half8 bh = *(const half8*)(WH + (32 * j + i32) * 272 + ko), bl = *(const half8*)(WL + (32 * j + i32) * 272 + ko);
                    acc[j] = __builtin_amdgcn_mfma_f32_32x32x16_f16(ah, bh, acc[j], 0, 0, 0);
                    acx[j] = __builtin_amdgcn_mfma_f32_32x32x16_f16(ah, bl, acx[j], 0, 0, 0);
                    acx[j] = __builtin_amdgcn_mfma_f32_32x32x16_f16(al, bh, acx[j], 0, 0, 0);
                }
            }
        }
#undef RT_LOAD
#pragma unroll
        for (int j = 0; j < 3; ++j)
#pragma unroll
            for (int i = 0; i < 16; ++i) acc[j][i] += acx[j][i] * (1.0f / 2048.0f);
        __syncthreads();
#pragma unroll
        for (int j = 0; j < 3; ++j)
#pragma unroll
            for (int i = 0; i < 16; ++i) part[((wid * 3 + j) * 16 + i) * 64 + lane] = acc[j][i];
        ssq[tid] = ss0; ssq[NTHR + tid] = ss1;
        __syncthreads();
        if (tid < 32) {
            float s = 0.f;
            const float* sr = ssq + (tid >> 4) * NTHR + (tid & 15) * 32;
#pragma unroll
            for (int w = 0; w < 32; ++w) s += sr[w];
            const float rs = 1.0f / sqrtf(s * (1.0f / D_) + 1e-6f);
            rstd_s[tid] = rs; p.rstd2[t0 + tid] = rs;
        }
        __syncthreads();
        for (int idx = tid; idx < 32 * 72; idx += NTHR) {
            const int tok = idx / 72, c = idx % 72, j = c >> 5, col = c & 31;
            const int hh = (tok >> 2) & 1, reg = (tok & 3) + 4 * (tok >> 3), ln = col + 32 * hh;
            float s = 0.f;
#pragma unroll
            for (int w = 0; w < 8; ++w) s += part[((w * 3 + j) * 16 + reg) * 64 + ln];
            logit[tok * 72 + c] = s * rstd_s[tok] + (c < 8 ? p.b_rg[c] : p.b_re[c - 8]);
        }
        __syncthreads();
        if (tid < 32) {
            const float* lg = logit + tid * 72;
            int gi = 0; float gm = lg[0];
#pragma unroll
            for (int g = 1; g < 8; ++g) if (lg[g] > gm) { gm = lg[g]; gi = g; }
            float se = 0.f;
#pragma unroll
            for (int g = 0; g < 8; ++g) se += expf(lg[g] - gm);
            const float pg = 1.0f / se;
            const float* el = lg + 8 + gi * 8;
            int e0 = 0; float v0 = el[0];
#pragma unroll
            for (int j = 1; j < 8; ++j) if (el[j] > v0) { v0 = el[j]; e0 = j; }
            int e1 = -1; float v1 = -INFINITY;
#pragma unroll
            for (int j = 0; j < 8; ++j) if (j != e0 && el[j] > v1) { v1 = el[j]; e1 = j; }
            const float w1 = 1.0f / (1.0f + expf(v0 - v1)), w0 = 1.0f - w1;
            const int t = t0 + tid;
            p.eid[2 * t] = gi * 8 + e0; p.eid[2 * t + 1] = gi * 8 + e1;
            p.gate[2 * t] = pg * w0; p.gate[2 * t + 1] = pg * w1;
        }
        __syncthreads();
    }
}

__device__ __forceinline__ void phase_lists(const Params& p, char* smem) {
    int* wtab = (int*)smem;
    const int tid = phase_tid(), lane = tid & 63, wid = tid >> 6;
    for (int e = blockIdx.x; e < NEXP; e += gridDim.x) {
        int ev[32];
#pragma unroll
        for (int it = 0; it < 32; ++it) ev[it] = p.eid[it * NTHR + tid];
        __syncthreads();
#pragma unroll
        for (int it = 0; it < 32; ++it) {
            const unsigned long long m = __ballot(ev[it] == e);
            if (lane == 0) wtab[it * 8 + wid] = __popcll(m);
        }
        __syncthreads();
        if (wid == 0) {
            int c0 = wtab[4 * lane], c1 = wtab[4 * lane + 1], c2 = wtab[4 * lane + 2], c3 = wtab[4 * lane + 3];
            const int tot4 = c0 + c1 + c2 + c3;
            int inc = tot4;
#pragma unroll
            for (int o = 1; o < 64; o <<= 1) { const int t = __shfl_up(inc, o); if (lane >= o) inc += t; }
            const int ex = inc - tot4;
            wtab[4 * lane] = ex; wtab[4 * lane + 1] = ex + c0; wtab[4 * lane + 2] = ex + c0 + c1; wtab[4 * lane + 3] = ex + c0 + c1 + c2;
            if (lane == 63) { wtab[256] = inc; p.cnt[e] = inc; }
        }
        __syncthreads();
#pragma unroll
        for (int it = 0; it < 32; ++it) {
            const bool f = ev[it] == e;
            const unsigned long long m = __ballot(f);
            if (f) p.list[e * T_ + wtab[it * 8 + wid] + __popcll(m & ((1ull << lane) - 1ull))] = it * NTHR + tid;
        }
    }
}

__device__ __forceinline__ float silu_f(float v) { return v / (1.0f + __expf(-v)); }
#define MOE_A_BYTES (384 * 144)
#define MOE_BUF (MOE_A_BYTES + 128 * 144)
#define MOE_TAB (2 * MOE_BUF)
#define MOE_SLOT (MOE_TAB + 1024)

__device__ __forceinline__ void moe_tables(const Params& p, int* tab) {
    __syncthreads();
    if (threadIdx.x == 0) {
        int a = 0, b = 0;
        for (int e = 0; e < NEXP; ++e) { tab[e] = a; tab[65 + e] = b; const int c = p.cnt[e]; a += c <= 256 ? (c > 0 ? 1 : 0) : (c + 383) / 384; b += c; }
        tab[64] = a; tab[129] = b;
    }
    __syncthreads();
}

template <bool IS_GU, int MI>
__device__ __forceinline__ void moe_unit(const Params& p, char* smem, int tid, int e, int nt, int mt, int cnt, int rowoff, const int* lst) {
    constexpr int K = IS_GU ? D_ : DE, NK = K / 64, LDW = IS_GU ? 2 * DE : D_, RT = 128 * MI, NA = 2 * MI;
    const int lane = tid & 63, wid = tid >> 6, wm = wid >> 1, wn = wid & 1, r = lane & 31, h = lane >> 5;
    const int kgB = (wid >> 1) * 4 + (lane >> 4), ngl = lane & 15, nB = 64 * (wid & 1) + 4 * ngl;
    const f16* abase = IS_GU ? p.xm : p.Hbuf + (size_t)rowoff * DE;
    const int nch = __builtin_amdgcn_readfirstlane((min(cnt - mt * RT, RT) + 63) >> 6);
    unsigned aofs[NA];
    const int aoff0 = (tid >> 3) * 144 + (tid & 7) * 16;
#pragma unroll
    for (int i = 0; i < NA; ++i) {
        const int c = tid + NTHR * i, row = c >> 3, cc = c & 7;
        int grow = mt * RT + row; if (grow >= cnt) grow = cnt - 1;
        if (IS_GU) aofs[i] = (unsigned)(lst[grow] >> 1) * D_ + cc * 8;
        else aofs[i] = (unsigned)grow * DE + cc * 8;
    }
    const float* wB;
    if constexpr (IS_GU) wB = p.w_gu + (size_t)e * D_ * (2 * DE) + (ngl >> 3) * DE + nt * 64 + 32 * (wid & 1) + 4 * (ngl & 7);
    else wB = p.w_dn + (size_t)e * DE * D_ + nt * 128 + nB;
    wB += (size_t)(4 * kgB) * LDW;
    int boff[4];
#pragma unroll
    for (int ni = 0; ni < 4; ++ni) boff[ni] = MOE_A_BYTES + (nB + ni) * 144 + kgB * 8;
    f32x16 acc[MI][2];
#pragma unroll
    for (int mi = 0; mi < MI; ++mi)
#pragma unroll
        for (int j = 0; j < 2; ++j)
#pragma unroll
            for (int i = 0; i < 16; ++i) acc[mi][j][i] = 0.f;
    constexpr int DA = 2, DB = 2;
    u32x4 ra[DA][NA]; f32x4 rb[DB][4];
    const int afrag = (32 * MI * wm + r) * 144 + h * 16, bfrag = MOE_A_BYTES + (64 * wn + r) * 144 + h * 16;
#define MOE_LOADA(set, kt) do { _Pragma("unroll") for (int i = 0; i < NA; ++i) if (i < NA - 2 || i < nch) ra[set][i] = *(const u32x4*)(abase + aofs[i] + (kt) * 64); } while (0)
#define MOE_LOADB(set, kt) do { _Pragma("unroll") for (int j = 0; j < 4; ++j) rb[set][j] = *(const f32x4*)(wB + (size_t)((kt) * 64 + j) * LDW); } while (0)
#define MOE_WRITE(seta, setb, buf) do { char* Lb = smem + (buf) * MOE_BUF; _Pragma("unroll") for (int i = 0; i < NA; ++i) if (i < NA - 2 || i < nch) *(u32x4*)(Lb + aoff0 + i * 64 * 144) = ra[seta][i]; \
    _Pragma("unroll") for (int ni = 0; ni < 4; ++ni) { half4 hv; hv[0] = (f16)rb[setb][0][ni]; hv[1] = (f16)rb[setb][1][ni]; hv[2] = (f16)rb[setb][2][ni]; hv[3] = (f16)rb[setb][3][ni]; \
        *(half4*)(Lb + boff[ni]) = hv; } } while (0)
#define MOE_COMPUTE(buf, s0, s1) do { const char* Lb = smem + (buf) * MOE_BUF; _Pragma("unroll") for (int s = s0; s < s1; ++s) { \
        half8 af[MI], bf[2]; \
        _Pragma("unroll") for (int mi = 0; mi < MI; ++mi) af[mi] = *(const half8*)(Lb + afrag + mi * 32 * 144 + s * 32); \
        _Pragma("unroll") for (int j = 0; j < 2; ++j) bf[j] = *(const half8*)(Lb + bfrag + j * 32 * 144 + s * 32); \
        _Pragma("unroll") for (int mi = 0; mi < MI; ++mi) _Pragma("unroll") for (int j = 0; j < 2; ++j) acc[mi][j] = __builtin_amdgcn_mfma_f32_32x32x16_f16(bf[j], af[mi], acc[mi][j], 0, 0, 0); } } while (0)
#pragma unroll
    for (int t = 0; t < DB; ++t) { MOE_LOADB(t, t); if (t < DA) MOE_LOADA(t, t); }
    MOE_WRITE(0, 0, 0);
    MOE_LOADA(0, DA); MOE_LOADB(0, DB);
    __syncthreads();
#pragma unroll
    for (int kt = 0; kt < NK; ++kt) {
        const int t1 = kt + 1;
        MOE_COMPUTE(kt & 1, 0, 2);
        __builtin_amdgcn_sched_barrier(0);
        if (t1 < NK) {
            MOE_WRITE(t1 % DA, t1 % DB, t1 & 1);
            if (t1 + DA < NK) MOE_LOADA(t1 % DA, t1 + DA);
            if (t1 + DB < NK) MOE_LOADB(t1 % DB, t1 + DB);
        }
        __builtin_amdgcn_sched_barrier(0);
        MOE_COMPUTE(kt & 1, 2, 4);
        __syncthreads();
    }
#undef MOE_LOADA
#undef MOE_LOADB
#undef MOE_WRITE
#undef MOE_COMPUTE
#pragma unroll
    for (int mi = 0; mi < MI; ++mi) {
        const int row = mt * RT + 32 * MI * wm + 32 * mi + r;
        if (row < cnt) {
            const int a = lst[row];
            if (IS_GU) {
                const float rs = p.rstd2[a >> 1];
#pragma unroll
                for (int g = 0; g < 4; ++g) {
                    half4 hv;
#pragma unroll
                    for (int e2 = 0; e2 < 4; ++e2) { const float gg = acc[mi][0][4 * g + e2] * rs, uu = acc[mi][1][4 * g + e2] * rs; hv[e2] = (f16)(silu_f(gg) * uu); }
                    *(half4*)(p.Hbuf + (size_t)(rowoff + row) * DE + nt * 64 + 32 * wn + 8 * g + 4 * h) = hv;
                }
            } else {
                const float gt = p.gate[a];
#pragma unroll
                for (int j = 0; j < 2; ++j)
#pragma unroll
                    for (int g = 0; g < 4; ++g) {
                        half4 o; o[0] = (f16)(acc[mi][j][4 * g] * gt); o[1] = (f16)(acc[mi][j][4 * g + 1] * gt); o[2] = (f16)(acc[mi][j][4 * g + 2] * gt); o[3] = (f16)(acc[mi][j][4 * g + 3] * gt);
                        *(half4*)(p.Y2 + (size_t)a * D_ + nt * 128 + 64 * wn + 32 * j + 8 * g + 4 * h) = o;
                    }
            }
        }
    }
}

template <bool IS_GU>
__device__ __forceinline__ void phase_moe(const Params& p, char* smem) {
    constexpr int NTN = IS_GU ? 12 : 16;
    int* tab = (int*)(smem + MOE_TAB);
    volatile int* slot = (volatile int*)(smem + MOE_SLOT);
    moe_tables(p, tab);
    const int tid = phase_tid();
    const int own = (int)(xb_xcc_id() & 7u);
    unsigned* ctr0 = p.bar + (IS_GU ? 8192 : 8704);
    for (int lq = 0; lq < 8; ++lq) {
        const int label = (own + lq) & 7;
        unsigned* ctr = ctr0 + 64 * label;
        for (;;) {
            __syncthreads();
            if (tid == 0) *slot = (int)atomicAdd(ctr, 1u);
            __syncthreads();
            const int ticket = *slot;
            int e = -1, local = ticket;
#pragma unroll
            for (int i = 0; i < 8; ++i) {
                const int ee = label + 8 * i, nu = (tab[ee + 1] - tab[ee]) * NTN;
                if (e < 0) { if (local < nu) e = ee; else local -= nu; }
            }
            if (e < 0) break;
            const int mts = tab[e + 1] - tab[e], nt = local / mts, mt = local % mts;
            const int cnt = p.cnt[e], rowoff = tab[65 + e];
            const int* lst = p.list + e * T_;
            int tu = tid; asm volatile("" : "+v"(tu));
            if (cnt <= 256) moe_unit<IS_GU, 2>(p, smem, tu, e, nt, mt, cnt, rowoff, lst);
            else moe_unit<IS_GU, 3>(p, smem, tu, e, nt, mt, cnt, rowoff, lst);
        }
    }
}

__device__ __forceinline__ void phase_final(const Params& p, char* smem) {
    const int tid = phase_tid(), lane = tid & 63, wid = tid >> 6;
    for (int t = blockIdx.x * 8 + wid; t < T_; t += gridDim.x * 8) {
        f32x4 v[8]; float ss = 0.f;
#pragma unroll
        for (int i = 0; i < 8; ++i) {
            const int c = lane * 4 + i * 256;
            const f32x4 a = *(const f32x4*)(p.x1 + (size_t)t * D_ + c);
            const half4 b = *(const half4*)(p.Y2 + (size_t)(2 * t) * D_ + c);
            const half4 d = *(const half4*)(p.Y2 + (size_t)(2 * t + 1) * D_ + c);
#pragma unroll
            for (int e = 0; e < 4; ++e) v[i][e] = a[e] + (float)b[e] + (float)d[e];
            ss += v[i][0] * v[i][0] + v[i][1] * v[i][1] + v[i][2] * v[i][2] + v[i][3] * v[i][3];
        }
        ss = wave_sum(ss);
        const float rs = 1.0f / sqrtf(ss * (1.0f / D_) + 1e-6f);
#pragma unroll
        for (int i = 0; i < 8; ++i) {
            const int c = lane * 4 + i * 256;
            const f32x4 g = *(const f32x4*)(p.ln_f + c);
            f32x4 o; o[0] = v[i][0] * rs * g[0]; o[1] = v[i][1] * rs * g[1]; o[2] = v[i][2] * rs * g[2]; o[3] = v[i][3] * rs * g[3];
            *(f32x4*)(p.out + (size_t)t * D_ + c) = o;
        }
    }
}

extern __shared__ __attribute__((aligned(16))) char dyn_smem[];
__global__ void __launch_bounds__(NTHR, 2) mega(Params p) {
    char* smem = dyn_smem;
    volatile LAS unsigned* xbw = (volatile LAS unsigned*)(dyn_smem + LDS_BYTES - 16);
    if (threadIdx.x == 0) { xbw[0] = 0u; xbw[1] = 0u; xbw[2] = 0u; xbw[3] = 0u; }
    __syncthreads();
    XcdBarrier bar = xcd_barrier_post(p.bar, xbw);
    if (threadIdx.x == 0) xbw[2] = atomicAdd(&p.bar[9472 + 64 * (xb_xcc_id() & 7u)], 1u);
    phase_prologue(p, smem);
    xcd_barrier(bar);
    int cwg = blockIdx.x;
    {
        bool ok = (gridDim.x % 8u) == 0u;
        for (int j = 0; j < 8; ++j) ok = ok && (xb_ld(&p.bar[9472 + 64 * j]) == gridDim.x / 8u);
        if (ok) cwg = (int)((xb_xcc_id() & 7u) + 8u * xbw[2]);
        cwg = __builtin_amdgcn_readfirstlane(cwg);
    }
    phase_inproj(p, smem, cwg);
    {
        const int nun = (T_ / 256) * (NINP / 256), rem = nun % (int)gridDim.x;
        if (rem == 0) phase_deferred(p, smem, cwg, gridDim.x);
        else if (cwg >= rem) phase_deferred(p, smem, cwg - rem, gridDim.x - rem);
    }
    xcd_barrier(bar);
    phase_rwkvprep(p, smem);
    xcd_barrier(bar);
    phase_rwkv1(p, smem);
    xcd_barrier(bar);
    if (blockIdx.x < NH) phase_rwkv2_head(p, smem, blockIdx.x);
    phase_attn(p, smem);
    xcd_barrier(bar);
    phase_rwkv3(p, smem);
    xcd_barrier(bar);
    phase_outproj(p, smem, cwg);
    xcd_barrier(bar);
    phase_router(p, smem);
    xcd_barrier(bar);
    phase_lists(p, smem);
    xcd_barrier(bar);
    phase_moe<true>(p, smem);
    xcd_barrier(bar);
    phase_moe<false>(p, smem);
    xcd_barrier(bar);
    phase_final(p, smem);
}

static inline size_t align_up(size_t v, size_t a) { return (v + a - 1) / a * a; }

extern "C" void kernel_launch(void* const* d_in, const int* in_sizes, int n_in, void* d_out, int out_size, void* d_ws, size_t ws_size, hipStream_t stream) {
    Params p{};
    p.x = (const float*)d_in[0]; p.pos = (const int*)d_in[1]; p.ln1 = (const float*)d_in[2]; p.w_in = (const float*)d_in[3]; p.mu = (const float*)d_in[4];
    p.w_decay0 = (const float*)d_in[5]; p.w_decay_up = (const float*)d_in[6]; p.a0 = (const float*)d_in[7]; p.w_a_up = (const float*)d_in[8]; p.w_g_up = (const float*)d_in[9];
    p.k_k = (const float*)d_in[10]; p.k_a = (const float*)d_in[11]; p.r_k = (const float*)d_in[12]; p.gn_w = (const float*)d_in[13]; p.gn_b = (const float*)d_in[14];
    p.sinks = (const float*)d_in[15]; p.w_out = (const float*)d_in[16]; p.ln2 = (const float*)d_in[17]; p.w_rg = (const float*)d_in[18]; p.b_rg = (const float*)d_in[19];
    p.w_re = (const float*)d_in[20]; p.b_re = (const float*)d_in[21]; p.w_gu = (const float*)d_in[22]; p.w_dn = (const float*)d_in[23]; p.ln_f = (const float*)d_in[24];
    p.out = (float*)d_out;
    char* ws = (char*)d_ws; size_t off = 0;
    auto take = [&](size_t bytes) { char* r = ws + off; off = align_up(off + bytes, 256); return r; };
    p.bar = (unsigned*)take(64 * 1024);
    p.Wr = (float*)take((size_t)D_ * 96 * 4);
    p.WrH = (f16*)take((size_t)96 * D_ * 2); p.WrL = (f16*)take((size_t)96 * D_ * 2);
    p.xh = (f16*)take((size_t)T_ * D_ * 2); p.rstd1 = (float*)take(T_ * 4);
    p.WinT = (f16*)take((size_t)NINP * D_ * 2); p.WoutT = (f16*)take((size_t)D_ * D_ * 2);
    p.WduT = (f16*)take(RW * 64 * 2); p.WauT = (f16*)take(RW * 64 * 2); p.WguT = (f16*)take(RW * 160 * 2);
    p.ropec = (float*)take(T_ * 32 * 4); p.ropes = (float*)take(T_ * 32 * 4);
    p.P = (f16*)take((size_t)T_ * NINP * 2);
    p.qr = (f16*)take((size_t)T_ * 1024 * 2); p.kr = (f16*)take((size_t)T_ * 256 * 2);
    p.Wd = (float*)take((size_t)T_ * RW * 4); p.G = (f16*)take((size_t)T_ * RW * 2);
    p.R = (f16*)take((size_t)T_ * RW * 2); p.K2 = (f16*)take((size_t)T_ * RW * 2); p.V = (f16*)take((size_t)T_ * RW * 2);
    p.A = (f16*)take((size_t)T_ * RW * 2); p.B = (f16*)take((size_t)T_ * RW * 2); p.bonus = (float*)take(T_ * NH * 4);
    p.PT = (f16*)take((size_t)NH * NCHK * 4096 * 2); p.segQ = (f16*)take((size_t)NH * NCHK * 4096 * 2); p.Sst = (f16*)take((size_t)NH * NCHK * 4096 * 2);
    p.ycat = (f16*)take((size_t)T_ * D_ * 2);
    p.x1 = (float*)take((size_t)T_ * D_ * 4); p.xm = (f16*)take((size_t)T_ * D_ * 2); p.rstd2 = (float*)take(T_ * 4);
    p.eid = (int*)take(2 * T_ * 4); p.gate = (float*)take(2 * T_ * 4); p.cnt = (int*)take(NEXP * 4); p.list = (int*)take((size_t)NEXP * T_ * 4);
    p.Hbuf = (f16*)take((size_t)2 * T_ * DE * 2); p.Y2 = (f16*)take((size_t)2 * T_ * D_ * 2); p.Wdn16 = (f16*)take((size_t)NEXP * DE * D_ * 2);

    static int grid = 0;
    if (!grid) {
        int dev = 0, cus = 0, per_cu = 0;
        (void)hipGetDevice(&dev);
        (void)hipDeviceGetAttribute(&cus, hipDeviceAttributeMultiprocessorCount, dev);
        (void)hipFuncSetAttribute((const void*)mega, hipFuncAttributeMaxDynamicSharedMemorySize, LDS_BYTES);
        (void)hipOccupancyMaxActiveBlocksPerMultiprocessor(&per_cu, mega, NTHR, LDS_BYTES);
        if (per_cu < 1) per_cu = 1;
        grid = cus * 1;
        if (grid <= 0) grid = 256;
    }
    (void)hipMemsetAsync(p.bar, 0, 64 * 1024, stream);
    mega<<<dim3(grid), dim3(NTHR), LDS_BYTES, stream>>>(p);
}
```

```cpp
#include <hip/hip_runtime.h>
#include <stdint.h>
#include <type_traits>

typedef _Float16 f16;
typedef _Float16 half8 __attribute__((ext_vector_type(8)));
typedef _Float16 half4 __attribute__((ext_vector_type(4)));
typedef _Float16 half2v __attribute__((ext_vector_type(2)));
typedef float f32x16 __attribute__((ext_vector_type(16)));
typedef float f32x4 __attribute__((ext_vector_type(4)));
typedef unsigned u32x4 __attribute__((ext_vector_type(4)));
typedef const __attribute__((address_space(4))) float* cfp;

#define T_ 8192
#define D_ 2048
#define NIN 4896
#define NINP 5120
#define RW 1024
#define NH 16
#define C_R 0
#define C_K 1024
#define C_V 2048
#define C_WD 3072
#define C_AD 3136
#define C_GD 3200
#define C_AQ 3360
#define C_AK 4384
#define C_AV 4640
#define NSEG 64
#define SEGL 128
#define DE 768
#define NEXP 64
#define NTHR 512
#define LDS_BYTES (150 * 1024)

struct Params {
    const float* x; const int* pos; const float* ln1; const float* w_in; const float* mu; const float* w_decay0; const float* w_decay_up;
    const float* a0; const float* w_a_up; const float* w_g_up; const float* k_k; const float* k_a; const float* r_k; const float* gn_w; const float* gn_b;
    const float* sinks; const float* w_out; const float* ln2; const float* w_rg; const float* b_rg; const float* w_re; const float* b_re;
    const float* w_gu; const float* w_dn; const float* ln_f;
    float* out;
    unsigned* bar;
    float* Wr; f16* WrH; f16* WrL; f16* xh; float* rstd1; f16* WinT; f16* WoutT; f16* WduT; f16* WauT; f16* WguT; float* ropec; float* ropes;
    f16* P; f16* qr; f16* kr;
    float* Wd; f16* G; f16* R; f16* K2; f16* V; f16* A; f16* B; float* bonus;
    f16* PT; f16* segQ; f16* Sst; f16* ycat; float* x1; f16* xm; float* rstd2;
    int* eid; float* gate; int* cnt; int* list; f16* Hbuf; f16* Y2; f16* Wdn16;
};


#define XB_TMO      128
#define XB_XCNT(j)  (256  + 64 * (j))
#define XB_XSUB(j)  (1280 + 64 * (j))
#define XB_XGEN(j)  (2304 + 64 * (j))
#define XB_TOP      3328
#define XB_TOPGEN   3392
#define XCD_BAR_WORDS 3456
#define XB_SPIN_CAP (1u << 18)
#define LAS __attribute__((address_space(3)))

__device__ __forceinline__ unsigned xb_ld(unsigned* p)              { return __hip_atomic_load(p, __ATOMIC_RELAXED, __HIP_MEMORY_SCOPE_AGENT); }
__device__ __forceinline__ unsigned xb_add(unsigned* p, unsigned v) { return __hip_atomic_fetch_add(p, v, __ATOMIC_RELAXED, __HIP_MEMORY_SCOPE_AGENT); }
__device__ __forceinline__ unsigned xb_xcc_id() { return (unsigned)__builtin_amdgcn_s_getreg((3 << 11) | 20) & 0xFu; }
#define XB_SPIN(cond, bar) do { unsigned _sp = 0; while (cond) { __builtin_amdgcn_s_sleep(1); \
    if ((++_sp & 255u) == 0u) { if (xb_ld(&(bar)[XB_TMO])) break; if (_sp > XB_SPIN_CAP) { atomicAdd(&(bar)[XB_TMO], 1u); break; } } } } while (0)

struct XcdBarrier { unsigned* bar; unsigned x; volatile LAS unsigned* st; };

__device__ __forceinline__ XcdBarrier xcd_barrier_post(unsigned* bar, volatile LAS unsigned* st) {
    XcdBarrier b; b.bar = bar; b.x = xb_xcc_id(); b.st = st;
    if (threadIdx.x == 0) (void)xb_add(&bar[XB_XCNT(b.x)], 1u);
    return b;
}
__device__ __forceinline__ void xcd_barrier_complete(unsigned* bar, unsigned x, unsigned& nloc, unsigned& nx) {
    const unsigned G = gridDim.x * gridDim.y * gridDim.z;
    unsigned sum, cnt, mine, sp = 0u;
    for (;;) {
        sum = 0u; cnt = 0u; mine = 0u;
#pragma unroll
        for (unsigned j = 0; j < 16; ++j) { const unsigned c = xb_ld(&bar[XB_XCNT(j)]); sum += c; cnt += (c > 0u) ? 1u : 0u; mine = (j == x) ? c : mine; }
        if (sum == G) break;
        __builtin_amdgcn_s_sleep(1);
        if ((++sp & 255u) == 0u) { if (xb_ld(&bar[XB_TMO])) break; if (sp > XB_SPIN_CAP) { atomicAdd(&bar[XB_TMO], 1u); break; } }
    }
    nloc = mine > 0u ? mine : 1u; nx = cnt > 0u ? cnt : 1u;
}
__device__ __forceinline__ void xcd_barrier(const XcdBarrier& b) {
    asm volatile("s_waitcnt vmcnt(0)" ::: "memory");
    __syncthreads();
    if (threadIdx.x == 0) {
        unsigned* bar = b.bar;
        __builtin_amdgcn_s_waitcnt(0);
        unsigned nloc = b.st[0], nx = b.st[1];
        if (nloc == 0u) { xcd_barrier_complete(bar, b.x, nloc, nx); b.st[0] = nloc; b.st[1] = nx; }
        const unsigned old = xb_add(&bar[XB_XSUB(b.x)], 1u);
        const unsigned gen = old / nloc;
        if (old + 1u == (gen + 1u) * nloc) {
            __builtin_amdgcn_fence(__ATOMIC_RELEASE, "agent");
            asm volatile("s_waitcnt vmcnt(0)" ::: "memory");
            const unsigned og = xb_add(&bar[XB_TOP], 1u);
            const unsigned tg = og / nx;
            if (og + 1u == (tg + 1u) * nx) xb_add(&bar[XB_TOPGEN], 1u);
            else XB_SPIN(xb_ld(&bar[XB_TOPGEN]) == tg, bar);
            __builtin_amdgcn_fence(__ATOMIC_ACQUIRE, "agent");
            xb_add(&bar[XB_XGEN(b.x)], 1u);
            asm volatile("s_waitcnt vmcnt(0)" ::: "memory");
        } else {
            XB_SPIN(xb_ld(&bar[XB_XGEN(b.x)]) == gen, bar);
            __builtin_amdgcn_fence(__ATOMIC_ACQUIRE, "agent");
            asm volatile("s_waitcnt vmcnt(0)" ::: "memory");
        }
    }
    __syncthreads();
}

#define WAVE_LDS_SYNC() asm volatile("s_waitcnt lgkmcnt(0)" ::: "memory")
__device__ __forceinline__ int phase_tid() { int t = threadIdx.x; asm volatile("" : "+v"(t)); return t; }

__device__ __forceinline__ float wave_sum(float v) {
#pragma unroll
    for (int o = 32; o > 0; o >>= 1) v += __shfl_xor(v, o);
    return v;
}

__device__ __forceinline__ void transpose_cvt(char* smem, const float* src, int K, int N, int Npad, f16* dst, int bid, int nb) {
    float* t = (float*)smem;
    const int tid = phase_tid();
    const int ktiles = (K + 63) / 64, ntiles = Npad / 64;
    for (int tile = bid; tile < ktiles * ntiles; tile += nb) {
        const int kb = tile % ktiles, nbk = tile / ktiles;
        __syncthreads();
        {
            const int n_l = tid & 63, k_l0 = tid >> 6;
#pragma unroll
            for (int i = 0; i < 8; ++i) {
                const int k_l = k_l0 + 8 * i, k = kb * 64 + k_l, n = nbk * 64 + n_l;
                float v = 0.f;
                if (k < K && n < N) v = src[(size_t)k * N + n];
                t[k_l * 65 + n_l] = v;
            }
        }
        __syncthreads();
        {
            const int k_l = tid & 63, n_l0 = tid >> 6;
#pragma unroll
            for (int i = 0; i < 8; ++i) {
                const int n_l = n_l0 + 8 * i, k = kb * 64 + k_l, n = nbk * 64 + n_l;
                if (k < K) dst[(size_t)n * K + k] = (f16)t[k_l * 65 + n_l];
            }
        }
    }
}

__device__ __forceinline__ void transpose_cvt_fast(char* smem, const float* src, int K, int N, int Npad, f16* dst, int bid, int nb) {
    const int tid = phase_tid(), lane = tid & 63, wid = tid >> 6;
    const int kgB = (wid >> 1) * 4 + (lane & 3), ngl = lane >> 2, nB = 64 * (wid & 1) + 4 * ngl;
    const int ktiles = K / 64, ntiles = Npad / 128;
    for (int tile = bid; tile < ktiles * ntiles; tile += nb) {
        const int kb = tile % ktiles, nbk = tile / ktiles, k0 = kb * 64, n0 = nbk * 128;
        f32x4 w[4];
#pragma unroll
        for (int j = 0; j < 4; ++j) {
            w[j] = (f32x4){0.f, 0.f, 0.f, 0.f};
            if (n0 + nB < N) w[j] = *(const f32x4*)(src + (size_t)(k0 + 4 * kgB + j) * N + n0 + nB);
        }
        __syncthreads();
#pragma unroll
        for (int ni = 0; ni < 4; ++ni) {
            const int n = nB + ni;
            half4 hv; hv[0] = (f16)w[0][ni]; hv[1] = (f16)w[1][ni]; hv[2] = (f16)w[2][ni]; hv[3] = (f16)w[3][ni];
            *(half4*)(smem + n * 128 + ((((kgB >> 1) ^ ((n >> 1) & 7))) << 4) + (kgB & 1) * 8) = hv;
        }
        __syncthreads();
#pragma unroll
        for (int i = 0; i < 2; ++i) {
            const int c = tid + NTHR * i, nl = c >> 3, cc = c & 7;
            *(u32x4*)(dst + (size_t)(n0 + nl) * K + k0 + cc * 8) = *(const u32x4*)(smem + nl * 128 + ((cc ^ ((nl >> 1) & 7)) << 4));
        }
    }
}

__device__ __forceinline__ void phase_prologue(const Params& p, char* smem) {
    const int tid = phase_tid(), lane = tid & 63, wid = tid >> 6, bid = blockIdx.x, nb = gridDim.x;
    f32x4 g1[8];
#pragma unroll
    for (int i = 0; i < 8; ++i) g1[i] = *(const f32x4*)(p.ln1 + lane * 4 + i * 256);
    for (int row = bid * 8 + wid; row < T_; row += nb * 8) {
        const float* xr = p.x + (size_t)row * D_;
        float ss = 0.f;
        f32x4 xv8[8];
#pragma unroll
        for (int i = 0; i < 8; ++i) xv8[i] = *(const f32x4*)(xr + lane * 4 + i * 256);
        asm volatile("" ::: "memory");
#pragma unroll
        for (int i = 0; i < 8; ++i) {
            const int c = lane * 4 + i * 256;
            const f32x4 v = xv8[i];
            const f32x4 g = g1[i];
            ss += v[0] * v[0] + v[1] * v[1] + v[2] * v[2] + v[3] * v[3];
            half4 hv; hv[0] = (f16)(v[0] * g[0]); hv[1] = (f16)(v[1] * g[1]); hv[2] = (f16)(v[2] * g[2]); hv[3] = (f16)(v[3] * g[3]);
            *(half4*)(p.xh + (size_t)row * D_ + c) = hv;
        }
        ss = wave_sum(ss);
        if (lane == 0) p.rstd1[row] = 1.0f / sqrtf(ss * (1.0f / D_) + 1e-6f);
    }
    transpose_cvt_fast(smem, p.w_in, D_, NIN, NINP, p.WinT, bid, nb);
    for (int idx = bid * NTHR + tid; idx < NH * 2 * 18 * 64; idx += nb * NTHR) {
        const int ln = idx & 63, f = idx >> 6, s18 = f % 18, hj = f / 18;
        const int ch = (hj >> 1) * 64 + 32 * (hj & 1) + (ln & 31), hq = ln >> 5;
        const float* src; int s; f16* dst;
        if (s18 < 10) { src = p.w_g_up; s = s18; dst = p.WguT + ((size_t)(hj * 10 + s) * 64 + ln) * 8; }
        else if (s18 < 14) { src = p.w_decay_up; s = s18 - 10; dst = p.WduT + ((size_t)(hj * 4 + s) * 64 + ln) * 8; }
        else { src = p.w_a_up; s = s18 - 14; dst = p.WauT + ((size_t)(hj * 4 + s) * 64 + ln) * 8; }
        half8 o;
#pragma unroll
        for (int e = 0; e < 8; ++e) o[e] = (f16)src[(size_t)(16 * s + 8 * hq + e) * RW + ch];
        *(half8*)dst = o;
    }
}

__device__ __forceinline__ void phase_deferred(const Params& p, char* smem, int bid, int nb) {
    const int tid = phase_tid();
    transpose_cvt_fast(smem, p.w_out, D_, D_, D_, p.WoutT, bid, nb);
    for (int idx = bid * NTHR + tid; idx < D_ * 96; idx += nb * NTHR) {
        const int c = idx / D_, k = idx % D_;
        const float w = c < 8 ? p.w_rg[k * 8 + c] : (c < 72 ? p.w_re[k * 64 + (c - 8)] : 0.f);
        const f16 hi = (f16)w;
        p.WrH[idx] = hi; p.WrL[idx] = (f16)((w - (float)hi) * 2048.0f);
    }
    {
        const double inv = pow(10000.0, -(double)(tid & 31) / 32.0);
        for (int idx = bid * NTHR + tid; idx < T_ * 32; idx += nb * NTHR) {
            const int t = idx >> 5;
            double ang = (double)p.pos[t] * inv;
            ang -= 6.283185307179586476925 * rint(ang * 0.15915494309189533577);
            const float af = (float)ang;
            p.ropec[idx] = cosf(af); p.ropes[idx] = sinf(af);
        }
    }
}

template <int BK> struct GemmCfg { static constexpr int STRIDE = BK * 2 + 16; static constexpr int NCH = BK / 32; static constexpr int B_OFF = 128 * STRIDE; };

template <int BK, bool BF32, class Epi>
__device__ __forceinline__ void gemm_tile(char* smem, int K, const f16* const (&aptr)[GemmCfg<BK>::NCH], const f16* const (&bptr)[GemmCfg<BK>::NCH],
                                          const float* wB, int ldw, const Epi& epi) {
    constexpr int STRIDE = GemmCfg<BK>::STRIDE, NCH = GemmCfg<BK>::NCH, B_OFF = GemmCfg<BK>::B_OFF;
    const int tid = phase_tid(), lane = tid & 63, wid = tid >> 6, wm = wid >> 1, wn = wid & 1, r = lane & 31, h = lane >> 5;
    char* As = smem; char* Bs = smem + B_OFF;
    f32x16 acc0, acc1;
#pragma unroll
    for (int i = 0; i < 16; ++i) { acc0[i] = 0.f; acc1[i] = 0.f; }
    u32x4 ra[NCH], rb[NCH]; f32x4 rw[4];
    int aoff[NCH];
#pragma unroll
    for (int i = 0; i < NCH; ++i) { const int c = tid + NTHR * i; aoff[i] = (c / (BK / 8)) * STRIDE + (c % (BK / 8)) * 16; }
    const int nk = K / BK;
#pragma unroll
    for (int i = 0; i < NCH; ++i) ra[i] = *(const u32x4*)(aptr[i]);
    if constexpr (BF32) {
#pragma unroll
        for (int j = 0; j < 4; ++j) rw[j] = *(const f32x4*)(wB + (size_t)(4 * (tid >> 5) + j) * ldw);
    } else {
#pragma unroll
        for (int i = 0; i < NCH; ++i) rb[i] = *(const u32x4*)(bptr[i]);
    }
    for (int kt = 0; kt < nk; ++kt) {
        __syncthreads();
#pragma unroll
        for (int i = 0; i < NCH; ++i) *(u32x4*)(As + aoff[i]) = ra[i];
        if constexpr (BF32) {
            const int ng = tid & 31, kg = tid >> 5;
#pragma unroll
            for (int ni = 0; ni < 4; ++ni) {
                half4 hv; hv[0] = (f16)rw[0][ni]; hv[1] = (f16)rw[1][ni]; hv[2] = (f16)rw[2][ni]; hv[3] = (f16)rw[3][ni];
                *(half4*)(Bs + (4 * ng + ni) * STRIDE + kg * 8) = hv;
            }
        } else {
#pragma unroll
            for (int i = 0; i < NCH; ++i) *(u32x4*)(Bs + aoff[i]) = rb[i];
        }
        __syncthreads();
        if (kt + 1 < nk) {
            const int k0 = (kt + 1) * BK;
#pragma unroll
            for (int i = 0; i < NCH; ++i) ra[i] = *(const u32x4*)(aptr[i] + k0);
            if constexpr (BF32) {
#pragma unroll
                for (int j = 0; j < 4; ++j) rw[j] = *(const f32x4*)(wB + (size_t)(k0 + 4 * (tid >> 5) + j) * ldw);
            } else {
#pragma unroll
                for (int i = 0; i < NCH; ++i) rb[i] = *(const u32x4*)(bptr[i] + k0);
            }
        }
#pragma unroll
        for (int s = 0; s < BK / 16; ++s) {
            const half8 a = *(const half8*)(As + (32 * wm + r) * STRIDE + (16 * s + 8 * h) * 2);
            const half8 b0 = *(const half8*)(Bs + (64 * wn + r) * STRIDE + (16 * s + 8 * h) * 2);
            const half8 b1 = *(const half8*)(Bs + (64 * wn + 32 + r) * STRIDE + (16 * s + 8 * h) * 2);
            acc0 = __builtin_amdgcn_mfma_f32_32x32x16_f16(b0, a, acc0, 0, 0, 0);
            acc1 = __builtin_amdgcn_mfma_f32_32x32x16_f16(b1, a, acc1, 0, 0, 0);
        }
    }
    epi(32 * wm + r, 64 * wn + 4 * h, acc0, acc1);
}

template <int BK> __device__ __forceinline__ int ch_row(int i) { return (threadIdx.x + NTHR * i) / (BK / 8); }
template <int BK> __device__ __forceinline__ int ch_col(int i) { return ((threadIdx.x + NTHR * i) % (BK / 8)) * 8; }

namespace pg8 {
#define PG8_LAS __attribute__((address_space(3)))
typedef unsigned short bf16_t;
typedef _Float16 bf16x8 __attribute__((ext_vector_type(8)));
typedef float f32x4 __attribute__((ext_vector_type(4)));
typedef unsigned u32x4 __attribute__((ext_vector_type(4)));
constexpr int BM = 256, BK = 64, HALF = 128, HTB = HALF * BK * 2  , STAGE_BYTES = 8 * HTB, NXCD = 8, WGM = 8;

__host__ __device__ __forceinline__ int lds_byte(int r, int c) { const int st = (r >> 4) * 2 + (c >> 5), rr = r & 15, cc = c & 31, ob = rr * 64 + cc * 2; return st * 1024 + (ob ^ (((ob >> 9) & 1) << 5)); }
__host__ __device__ __forceinline__ void stage_rc(int b, int& R, int& C) { const int st = b / 1024, sb = b % 1024, swz = sb ^ (((sb >> 9) & 1) << 5); R = (st >> 1) * 16 + swz / 64; C = (st & 1) * 32 + (swz % 64) / 2; }
__host__ __device__ __forceinline__ int perm32(int rho) { const int n = rho >> 4, i = rho & 15; return 8 * (i >> 2) + 4 * n + (i & 3); }

struct Unit { int pm, pn; };
struct Gemm { const bf16_t* A; const bf16_t* Bt; int M, N, K; };

struct StaticOrder {
    int nM, nN, nwg, G, c;
    __host__ __device__ void init(int M, int N, int G_, int c_) { nM = M / BM; nN = N / BM; nwg = nM * nN; G = G_; c = c_; }
    __host__ __device__ bool next(int i, Unit& u) const {
        const long L = (long)i * G + c; if (L >= nwg) return false;
        int wgid = (int)L; { const int q = nwg / NXCD, r = nwg % NXCD, xcd = wgid % NXCD, off = wgid / NXCD; wgid = (xcd < r ? xcd * (q + 1) : r * (q + 1) + (xcd - r) * q) + off; }
        const int nig = WGM * nN, gid = wgid / nig, fm = gid * WGM, gsz = (nM - fm) < WGM ? (nM - fm) : WGM;
        u.pm = fm + ((wgid % nig) % gsz); u.pn = (wgid % nig) / gsz; return true;
    }
    __device__ __forceinline__ void a_ready(const Unit&) const {}
    __device__ __forceinline__ void done(const Unit&) const {}
};
struct EpiRowScaleF16 {
    static constexpr bool PERM = true, AFTER_DRAIN = false;
    _Float16* __restrict__ O; int ldc; const float* __restrict__ rowscale;
    __device__ __forceinline__ void operator()(const f32x4 (&acc)[2][2][4][2], const Unit& u, int wr, int wc, int fr, int fq) const {
        typedef _Float16 h8 __attribute__((ext_vector_type(8)));
        const int row0 = u.pm * BM + wr * 64 + fr, col0 = u.pn * BM + wc * 32 + 8 * fq;
        float scv[2][4];
#pragma unroll
        for (int ai = 0; ai < 2; ++ai)
#pragma unroll
            for (int m = 0; m < 4; ++m) scv[ai][m] = rowscale[row0 + ai * HALF + m * 16];
#pragma unroll
        for (int ai = 0; ai < 2; ++ai)
#pragma unroll
            for (int m = 0; m < 4; ++m) {
                const int row = row0 + ai * HALF + m * 16; const float sc = scv[ai][m];
                _Float16* rowp = O + (size_t)row * ldc + col0;
#pragma unroll
                for (int bj = 0; bj < 2; ++bj) {
                    const f32x4 v0 = acc[ai][bj][m][0], v1 = acc[ai][bj][m][1];
                    h8 w; w[0] = (_Float16)(v0[0] * sc); w[1] = (_Float16)(v0[1] * sc); w[2] = (_Float16)(v0[2] * sc); w[3] = (_Float16)(v0[3] * sc);
                    w[4] = (_Float16)(v1[0] * sc); w[5] = (_Float16)(v1[1] * sc); w[6] = (_Float16)(v1[2] * sc); w[7] = (_Float16)(v1[3] * sc);
                    *(h8*)(rowp + bj * HALF) = w;
                }
            }
    }
};
struct EpiResidualF32 {
    static constexpr bool PERM = false, AFTER_DRAIN = false;
    float* __restrict__ C; const float* __restrict__ base; int ldc;
    __device__ __forceinline__ void operator()(const f32x4 (&acc)[2][2][4][2], const Unit& u, int wr, int wc, int fr, int fq) const {
        const int row0 = u.pm * BM + wr * 64 + fr, col0 = u.pn * BM + wc * 32 + 4 * fq;
#pragma unroll
        for (int ai = 0; ai < 2; ++ai) {
            f32x4 t[4][2][2];
#pragma unroll
            for (int m = 0; m < 4; ++m)
#pragma unroll
                for (int bj = 0; bj < 2; ++bj)
#pragma unroll
                    for (int n = 0; n < 2; ++n) t[m][bj][n] = *(const f32x4*)(base + (size_t)(row0 + ai * HALF + m * 16) * ldc + col0 + bj * HALF + n * 16);
            __builtin_amdgcn_sched_barrier(0);
#pragma unroll
            for (int m = 0; m < 4; ++m)
#pragma unroll
                for (int bj = 0; bj < 2; ++bj)
#pragma unroll
                    for (int n = 0; n < 2; ++n) t[m][bj][n] += acc[ai][bj][m][n];
            __builtin_amdgcn_sched_barrier(0);
#pragma unroll
            for (int m = 0; m < 4; ++m)
#pragma unroll
                for (int bj = 0; bj < 2; ++bj)
#pragma unroll
                    for (int n = 0; n < 2; ++n) *(f32x4*)(C + (size_t)(row0 + ai * HALF + m * 16) * ldc + col0 + bj * HALF + n * 16) = t[m][bj][n];
            __builtin_amdgcn_sched_barrier(0);
        }
    }
};
template <class Epi, class Sched, bool STAMP = false>
__device__ __forceinline__ void gemm_phase(PG8_LAS unsigned char* lds, const Gemm g, const Sched& S, const Epi& E, unsigned long long* stamps) {
    const int tid = ::phase_tid()  , wid = __builtin_amdgcn_readfirstlane(tid >> 6), lane = tid & 63, wr = wid >> 2, wc = wid & 3, fr = lane & 15, fq = lane >> 4;
    const int K = g.K, nt = K / BK;
    int ts_lo = 0, ts_hi = 0, nts = 0; const unsigned long long rt_entry = STAMP ? (unsigned long long)wall_clock64() : 0ull;
#define PG8_STAMP() do { if (STAMP && wid == 0 && nts < 64) { const unsigned long long _c = (unsigned long long)clock64(); \
        ts_lo = (lane == nts) ? (int)(unsigned)_c : ts_lo; ts_hi = (lane == nts) ? (int)(unsigned)(_c >> 32) : ts_hi; ++nts; } } while (0)
    PG8_STAMP();
    unsigned voffA[2], voffB[2];
#pragma unroll
    for (int i = 0; i < 2; ++i) { int R, C; stage_rc(tid * 16 + i * 8192, R, C); const int Rb = Epi::PERM ? ((R & ~31) + perm32(R & 31)) : R;
        voffA[i] = (unsigned)(R * K + C) * 2u; voffB[i] = (unsigned)(Rb * K + C) * 2u; }
    const size_t kstep = (size_t)(BK * 2);
    const size_t hstep = (size_t)HALF * K * 2;
    const size_t tstep = 2 * hstep;
    const unsigned ldsw = (unsigned)wid * 1024u;
    const int aoff = lds_byte(wr * 64 + fr, fq * 8), boff = lds_byte(wc * 32 + fr, fq * 8);
#define PG8_SA(b, h) (((b) * 2 + (h)) * HTB)
#define PG8_SB(b, h) ((4 + (b) * 2 + (h)) * HTB)
#define PG8_STAGE(bufoff, gbase, voff) do { _Pragma("unroll") for (int _i = 0; _i < 2; ++_i) \
        __builtin_amdgcn_global_load_lds((const unsigned*)((const char*)(gbase) + (voff)[_i]), (PG8_LAS unsigned*)(lds + (bufoff) + ldsw + _i * 8192), 16, 0, 0); } while (0)
#define PG8_LDA(dst, b, h) do { _Pragma("unroll") for (int m = 0; m < 4; ++m) _Pragma("unroll") for (int k = 0; k < 2; ++k) dst[m][k] = *(const PG8_LAS bf16x8*)(lds + PG8_SA(b, h) + aoff + m * 2048 + k * 1024); } while (0)
#define PG8_LDB(dst, b, h) do { _Pragma("unroll") for (int n = 0; n < 2; ++n) _Pragma("unroll") for (int k = 0; k < 2; ++k) dst[n][k] = *(const PG8_LAS bf16x8*)(lds + PG8_SB(b, h) + boff + n * 2048 + k * 1024); } while (0)
#define PG8_MMA(ai, bj, At, Bt) do { __builtin_amdgcn_s_setprio(1); _Pragma("unroll") for (int m = 0; m < 4; ++m) _Pragma("unroll") for (int n = 0; n < 2; ++n) _Pragma("unroll") for (int k = 0; k < 2; ++k) \
        acc[ai][bj][m][n] = __builtin_amdgcn_mfma_f32_16x16x32_f16(Bt[n][k], At[m][k], acc[ai][bj][m][n], 0, 0, 0); __builtin_amdgcn_s_setprio(0); } while (0)
#define PG8_WAIT_V(n) asm volatile("s_waitcnt vmcnt(" #n ")" ::: "memory")
#define PG8_WAIT_L(n) asm volatile("s_waitcnt lgkmcnt(" #n ")" ::: "memory")
#define PG8_BAR __builtin_amdgcn_s_barrier()
#define PG8_SCHED __builtin_amdgcn_sched_barrier(0)
    Unit cur, nxt; int ui = 0;
    if (!S.next(0, cur)) return;
    f32x4 acc[2][2][4][2];
#pragma unroll
    for (int a = 0; a < 2; ++a)
#pragma unroll
        for (int b = 0; b < 2; ++b)
#pragma unroll
            for (int m = 0; m < 4; ++m)
#pragma unroll
                for (int n = 0; n < 2; ++n) acc[a][b][m][n] = (f32x4){0.f, 0.f, 0.f, 0.f};
    bf16x8 At[4][2], B0[2][2], B1[2][2];
    const char* cA = (const char*)g.A + (size_t)cur.pm * tstep; const char* cB = (const char*)g.Bt + (size_t)cur.pn * tstep;
    S.a_ready(cur);
    PG8_STAGE(PG8_SB(0, 0), cB, voffB); PG8_STAGE(PG8_SA(0, 0), cA, voffA); PG8_STAGE(PG8_SB(0, 1), cB + hstep, voffB); PG8_STAGE(PG8_SA(0, 1), cA + hstep, voffA);
    if (wr == 1) PG8_BAR;
    PG8_WAIT_V(4); PG8_BAR;
    PG8_STAGE(PG8_SB(1, 0), cB + kstep, voffB); PG8_STAGE(PG8_SA(1, 0), cA + kstep, voffA); PG8_STAGE(PG8_SB(1, 1), cB + hstep + kstep, voffB);
    PG8_WAIT_V(6); PG8_BAR;
    PG8_STAMP();
    for (;;) {
        const bool has_next = S.next(ui + 1, nxt);
        const char* nA = has_next ? (const char*)g.A + (size_t)nxt.pm * tstep : cA; const char* nB = has_next ? (const char*)g.Bt + (size_t)nxt.pn * tstep : cB;
        for (int t = 0; t < nt; t += 2) {
            const bool last = (t == nt - 2);
            const char* a1 = cA + (size_t)(t + 1) * kstep;
            const char* a2 = last ? nA : cA + (size_t)(t + 2) * kstep; const char* b2 = last ? nB : cB + (size_t)(t + 2) * kstep;
            const char* a3 = a2 + kstep; const char* b3 = b2 + kstep;
            if (last && has_next) S.a_ready(nxt);
            PG8_LDB(B0, 0, 0); PG8_SCHED; PG8_LDA(At, 0, 0); PG8_STAGE(PG8_SA(1, 1), a1 + hstep, voffA);
            PG8_WAIT_L(8); PG8_BAR; PG8_WAIT_L(0); PG8_MMA(0, 0, At, B0); PG8_BAR; PG8_SCHED;
            PG8_LDB(B1, 0, 1); PG8_STAGE(PG8_SB(0, 0), b2, voffB);
            PG8_BAR; PG8_WAIT_L(0); PG8_MMA(0, 1, At, B1); PG8_BAR;
            PG8_LDA(At, 0, 1); PG8_STAGE(PG8_SA(0, 0), a2, voffA);
            PG8_BAR; PG8_WAIT_L(0); PG8_MMA(1, 0, At, B0); PG8_BAR; PG8_SCHED;
            PG8_STAGE(PG8_SB(0, 1), b2 + hstep, voffB);
            PG8_WAIT_V(6); PG8_BAR; PG8_MMA(1, 1, At, B1); PG8_BAR;
            PG8_LDB(B0, 1, 0); PG8_SCHED; PG8_LDA(At, 1, 0); PG8_STAGE(PG8_SA(0, 1), a2 + hstep, voffA);
            PG8_WAIT_L(8); PG8_BAR; PG8_WAIT_L(0); PG8_MMA(0, 0, At, B0); PG8_BAR; PG8_SCHED;
            PG8_LDB(B1, 1, 1); PG8_STAGE(PG8_SB(1, 0), b3, voffB);
            PG8_BAR; PG8_WAIT_L(0); PG8_MMA(0, 1, At, B1); PG8_BAR;
            PG8_LDA(At, 1, 1); PG8_STAGE(PG8_SA(1, 0), a3, voffA);
            PG8_BAR; PG8_WAIT_L(0); PG8_MMA(1, 0, At, B0); PG8_BAR; PG8_SCHED;
            PG8_STAGE(PG8_SB(1, 1), b3 + hstep, voffB);
            PG8_WAIT_V(6); PG8_BAR; PG8_MMA(1, 1, At, B1); PG8_BAR;
        }
        PG8_STAMP();
        if constexpr (!Epi::AFTER_DRAIN) { E(acc, cur, wr, wc, fr, fq); S.done(cur); }
        PG8_STAMP();
        if (!has_next) break;
#pragma unroll
        for (int a = 0; a < 2; ++a)
#pragma unroll
            for (int b = 0; b < 2; ++b)
#pragma unroll
                for (int m = 0; m < 4; ++m)
#pragma unroll
                    for (int n = 0; n < 2; ++n) acc[a][b][m][n] = (f32x4){0.f, 0.f, 0.f, 0.f};
        cur = nxt; cA = nA; cB = nB; ++ui;
    }
    PG8_WAIT_V(0);
    if (wr == 0) PG8_BAR;
    PG8_BAR;
    if constexpr (Epi::AFTER_DRAIN) { E.fused(acc, cur, wr, wc, fr, fq, lds, wid, lane); S.done(cur); }
    PG8_STAMP();
    if (STAMP && wid == 0) { stamps[lane] = lane < nts ? (((unsigned long long)(unsigned)ts_hi << 32) | (unsigned)ts_lo) : 0ull;
        if (lane == 62) stamps[62] = rt_entry; if (lane == 63) stamps[63] = (unsigned long long)wall_clock64(); }
#undef PG8_STAMP
#undef PG8_SA
#undef PG8_SB
#undef PG8_STAGE
#undef PG8_LDA
#undef PG8_LDB
#undef PG8_MMA
#undef PG8_WAIT_V
#undef PG8_WAIT_L
#undef PG8_BAR
#undef PG8_SCHED
}
}

__device__ __forceinline__ void phase_inproj(const Params& p, char* smem, int cwg) {
    pg8::Gemm g; g.A = (const pg8::bf16_t*)p.xh; g.Bt = (const pg8::bf16_t*)p.WinT; g.M = T_; g.N = NINP; g.K = D_;
    pg8::StaticOrder so; so.init(T_, NINP, gridDim.x, cwg);
    pg8::EpiRowScaleF16 e; e.O = p.P; e.ldc = NINP; e.rowscale = p.rstd1;
    pg8::gemm_phase<pg8::EpiRowScaleF16, pg8::StaticOrder, false>((PG8_LAS unsigned char*)smem, g, so, e, nullptr);
}

__device__ __forceinline__ float ps_val(const f16* P, const float* mu, int t, int c) {
    const float cur = (float)P[(size_t)t * NINP + c];
    const float prv = t > 0 ? (float)P[(size_t)(t - 1) * NINP + c] : 0.f;
    return cur + (prv - cur) * mu[c];
}
#define RP_TD 0
#define RP_AD 18432
#define RP_SG 36864
#define RP_SGS 336
__device__ __forceinline__ float half_sum32(float v) {
    v += __shfl_xor(v, 1); v += __shfl_xor(v, 2); v += __shfl_xor(v, 4); v += __shfl_xor(v, 8); v += __shfl_xor(v, 16);
    return v;
}
#define RP2_TD 0
#define RP2_AD 4608
#define RP2_SG 9216
#define RP2_PS 20480
#define RP2_PSB 12672
__device__ __forceinline__ float fast_sigmoid(float v) { return __builtin_amdgcn_rcpf(1.0f + __expf(-v)); }
__device__ __forceinline__ void phase_rwkvprep(const Params& p, char* smem) {
    const int tid0 = phase_tid();
    for (int u = blockIdx.x; u < T_ / 32; u += gridDim.x) {
        int tid = tid0; asm volatile("" : "+v"(tid));
        const int lane = tid & 63, wid = tid >> 6, r = lane & 31, h = lane >> 5;
        const int t0 = u * 32;
        __syncthreads();
        {
            f16 cu[4][5], pr[4][5]; float mu5[5];
#pragma unroll
            for (int q = 0; q < 5; ++q) {
                const int cc = (lane + 64 * q < 288) ? lane + 64 * q : 287;
                mu5[q] = p.mu[C_WD + cc];
#pragma unroll
                for (int rr = 0; rr < 4; ++rr) {
                    const int t = t0 + wid * 4 + rr, tp = t > 0 ? t - 1 : 0;
                    cu[rr][q] = p.P[(size_t)t * NINP + C_WD + cc]; pr[rr][q] = p.P[(size_t)tp * NINP + C_WD + cc];
                }
            }
            asm volatile("" ::: "memory");
#pragma unroll
            for (int rr = 0; rr < 4; ++rr) {
                const int tl = wid * 4 + rr, t = t0 + tl;
#pragma unroll
                for (int q = 0; q < 5; ++q) {
                    const int c = lane + 64 * q;
                    if (c < 288) {
                        const float cur = (float)cu[rr][q], prv = t > 0 ? (float)pr[rr][q] : 0.f;
                        const float v = cur + (prv - cur) * mu5[q];
                        if (q == 0) *(f16*)(smem + RP2_TD + tl * 144 + c * 2) = (f16)(2.0f * fast_sigmoid(2.0f * v) - 1.0f);
                        else if (q == 1) *(f16*)(smem + RP2_AD + tl * 144 + (c - 64) * 2) = (f16)v;
                        else *(f16*)(smem + RP2_SG + tl * RP_SGS + (c - 128) * 2) = (f16)fast_sigmoid(v);
                    }
                }
            }
        }
        __syncthreads();
#define RP_ROW(i) ((i & 3) + 8 * (i >> 2))
        for (int hh = 0; hh < 2; ++hh) {
            const int hd = wid * 2 + hh;
            {
                f32x16 ag_[2];
#pragma unroll
                for (int j = 0; j < 2; ++j)
#pragma unroll
                    for (int i = 0; i < 16; ++i) ag_[j][i] = 0.f;
                half8 wg[2][10];
#pragma unroll
                for (int j = 0; j < 2; ++j)
#pragma unroll
                    for (int s = 0; s < 10; ++s) wg[j][s] = *(const half8*)(p.WguT + ((size_t)((hd * 2 + j) * 10 + s) * 64 + lane) * 8);
                asm volatile("" ::: "memory");
#pragma unroll
                for (int s = 0; s < 10; ++s) {
                    const half8 fg = *(const half8*)(smem + RP2_SG + r * RP_SGS + (16 * s + 8 * h) * 2);
#pragma unroll
                    for (int j = 0; j < 2; ++j) ag_[j] = __builtin_amdgcn_mfma_f32_32x32x16_f16(fg, wg[j][s], ag_[j], 0, 0, 0);
                }
#pragma unroll
                for (int j = 0; j < 2; ++j) {
                    f16* Gb = p.G + (size_t)(t0 + 4 * h) * RW + hd * 64 + 32 * j + r;
                    asm volatile("" : "+v"(Gb));
#pragma unroll
                    for (int i = 0; i < 16; ++i) Gb[(size_t)RP_ROW(i) * RW] = (f16)ag_[j][i];
                }
            }
            asm volatile("" ::: "memory");
            {
                char* Lp = smem + RP2_PS + wid * RP2_PSB;
                u32x4 pv[13];
#pragma unroll
                for (int i = 0; i < 13; ++i) {
                    int c = lane + 64 * i; if (c > 33 * 24 - 1) c = 33 * 24 - 1;
                    const int row = c / 24, rem = c - row * 24, arr = rem >> 3, cc = rem & 7;
                    int t = t0 - 1 + row; if (t < 0) t = 0;
                    pv[i] = *(const u32x4*)(p.P + (size_t)t * NINP + arr * 1024 + hd * 64 + cc * 8);
                }
                asm volatile("" ::: "memory");
#pragma unroll
                for (int i = 0; i < 13; ++i) {
                    const int c = lane + 64 * i;
                    if (c < 33 * 24) {
                        const int row = c / 24, rem = c - row * 24, arr = rem >> 3, cc = rem & 7;
                        u32x4 v = pv[i];
                        if (t0 - 1 + row < 0) { v[0] = 0u; v[1] = 0u; v[2] = 0u; v[3] = 0u; }
                        *(u32x4*)(Lp + row * 384 + arr * 128 + cc * 16) = v;
                    }
                }
            }
            WAVE_LDS_SYNC();
            const char* Lq = smem + RP2_PS + wid * RP2_PSB + 4 * h * 384;
            float kinv[16];
#pragma unroll
            for (int i = 0; i < 16; ++i) kinv[i] = 0.f;
#pragma unroll
            for (int j = 0; j < 2; ++j) {
                const int ch = hd * 64 + 32 * j + r;
                const float mk = p.mu[C_K + ch], kkw = p.k_k[ch];
#pragma unroll
                for (int i = 0; i < 16; ++i) {
                    const char* q = Lq + RP_ROW(i) * 384 + 128 + (32 * j + r) * 2;
                    const float p_ = (float)*(const f16*)q, c_ = (float)*(const f16*)(q + 384);
                    const float kk = (c_ + (p_ - c_) * mk) * kkw;
                    kinv[i] += kk * kk;
                }
            }
#pragma unroll
            for (int i = 0; i < 16; ++i) kinv[i] = 1.0f / fmaxf(sqrtf(half_sum32(kinv[i])), 1e-12f);
            float bs[16];
#pragma unroll
            for (int i = 0; i < 16; ++i) bs[i] = 0.f;
#pragma unroll
            for (int j = 0; j < 2; ++j) {
                const int ch = hd * 64 + 32 * j + r;
                const float mr = p.mu[C_R + ch], mk = p.mu[C_K + ch], mv = p.mu[C_V + ch];
                const float kkw = p.k_k[ch], kaw = p.k_a[ch], rkw = p.r_k[ch], wd0 = p.w_decay0[ch], a0v = p.a0[ch];
                f32x16 adj, aaj;
#pragma unroll
                for (int i = 0; i < 16; ++i) { adj[i] = 0.f; aaj[i] = 0.f; }
                half8 wdf[4], waf[4];
#pragma unroll
                for (int s = 0; s < 4; ++s) {
                    wdf[s] = *(const half8*)(p.WduT + ((size_t)((hd * 2 + j) * 4 + s) * 64 + lane) * 8);
                    waf[s] = *(const half8*)(p.WauT + ((size_t)((hd * 2 + j) * 4 + s) * 64 + lane) * 8);
                }
                asm volatile("" ::: "memory");
#pragma unroll
                for (int s = 0; s < 4; ++s) {
                    const half8 fa = *(const half8*)(smem + RP2_TD + r * 144 + (16 * s + 8 * h) * 2);
                    const half8 fb = *(const half8*)(smem + RP2_AD + r * 144 + (16 * s + 8 * h) * 2);
                    adj = __builtin_amdgcn_mfma_f32_32x32x16_f16(fa, wdf[s], adj, 0, 0, 0);
                    aaj = __builtin_amdgcn_mfma_f32_32x32x16_f16(fb, waf[s], aaj, 0, 0, 0);
                }
                size_t ob = ((size_t)(hd * (T_ / 16) + (t0 >> 4)) * 64 + 32 * j + r) * 16 + 4 * h;
                asm volatile("" : "+v"(ob));
#pragma unroll
                for (int ig = 0; ig < 4; ++ig) {
                    half4 r4, k4, v4, a4, b4; f32x4 w4;
#pragma unroll
                    for (int e = 0; e < 4; ++e) {
                        const int i = 4 * ig + e;
                        const char* q = Lq + RP_ROW(i) * 384 + (32 * j + r) * 2;
                        const float rp = (float)*(const f16*)q, kp = (float)*(const f16*)(q + 128), vp = (float)*(const f16*)(q + 256);
                        const float rc = (float)*(const f16*)(q + 384), kc = (float)*(const f16*)(q + 512), vc = (float)*(const f16*)(q + 640);
                        const float rr = rc + (rp - rc) * mr, k = kc + (kp - kc) * mk, v = vc + (vp - vc) * mv;
                        const float a = fast_sigmoid(a0v + aaj[i]);
                        const float lw = -0.60653066f * fast_sigmoid(wd0 + adj[i]);
                        const float kk = k * kkw * kinv[i];
                        const float k2 = k * (1.0f + (a - 1.0f) * kaw);
                        bs[i] += rr * k2 * rkw;
                        r4[e] = (f16)rr; k4[e] = (f16)k2; v4[e] = (f16)v; a4[e] = (f16)(-kk); b4[e] = (f16)(kk * a); w4[e] = lw;
                    }
                    const size_t o = ob + (size_t)(ig >> 1) * 1024 + (ig & 1) * 8;
                    *(half4*)(p.R + o) = r4; *(half4*)(p.K2 + o) = k4; *(half4*)(p.V + o) = v4; *(half4*)(p.A + o) = a4; *(half4*)(p.B + o) = b4;
                    *(f32x4*)(p.Wd + o) = w4;
                }
            }
            WAVE_LDS_SYNC();
#pragma unroll
            for (int i = 0; i < 16; ++i) {
                const float b = half_sum32(bs[i]);
                if (r == 0) p.bonus[(t0 + RP_ROW(i) + 4 * h) * NH + hd] = b;
            }
        }
#undef RP_ROW
    }
}

__device__ __forceinline__ void phase_rope(const Params& p, char* smem) {
    const int tid = phase_tid(), lane = tid & 63, wid = tid >> 6;
    for (int t = blockIdx.x * 8 + wid; t < T_; t += gridDim.x * 8) {
        for (int i = lane; i < 640; i += 64) {
            const int hd = i >> 5, j = i & 31;
            const float cs = p.ropec[t * 32 + j], sn = p.ropes[t * 32 + j];
            if (hd < 16) {
                const float x1 = (float)p.P[(size_t)t * NINP + C_AQ + hd * 64 + j], x2 = (float)p.P[(size_t)t * NINP + C_AQ + hd * 64 + 32 + j];
                p.qr[(size_t)t * 1024 + hd * 64 + j] = (f16)((x1 * cs - x2 * sn) * 0.125f);
                p.qr[(size_t)t * 1024 + hd * 64 + 32 + j] = (f16)((x2 * cs + x1 * sn) * 0.125f);
            } else {
                const int kh = hd - 16;
                const float x1 = (float)p.P[(size_t)t * NINP + C_AK + kh * 64 + j], x2 = (float)p.P[(size_t)t * NINP + C_AK + kh * 64 + 32 + j];
                p.kr[(size_t)t * 256 + kh * 64 + j] = (f16)(x1 * cs - x2 * sn);
                p.kr[(size_t)t * 256 + kh * 64 + 32 + j] = (f16)(x2 * cs + x1 * sn);
            }
        }
    }
}

#define SC_AR 0
#define SC_BK 4608
#define SC_AB 4608
#define SC_UB 6656
#define SC_VT 9216
#define SC_BH 11264
#define SC_KH 13312
#define SC_LB 15360
#define SC_LK 16384
#define SC_LAB 17408
#define SC_GAM 18432
#define SC_ERHO 18688
#define SC_S16 18944
#define SC_S16B 28160
#define SC_BYTES 37376
#define NCHK 64
#define CHS 8

__device__ __forceinline__ f32x16 mma16(const char* fa, const char* sb, f32x16 acc) {
    return __builtin_amdgcn_mfma_f32_32x32x16_f16(*(const half8*)fa, *(const half8*)sb, acc, 0, 0, 0);
}

struct ScIn { f32x4 w4[4]; half8 av[2], rv[2], bv[2], kv[2], vv[2]; };
__device__ __forceinline__ void subchunk_load(const Params& p, int hd, int tok0, int lane, ScIn& in) {
    const size_t o = ((size_t)(hd * (T_ / 16) + (tok0 >> 4)) * 64 + lane) * 16;
#pragma unroll
    for (int q = 0; q < 4; ++q) in.w4[q] = *(const f32x4*)(p.Wd + o + 4 * q);
#pragma unroll
    for (int q = 0; q < 2; ++q) {
        in.av[q] = *(const half8*)(p.A + o + 8 * q); in.rv[q] = *(const half8*)(p.R + o + 8 * q); in.bv[q] = *(const half8*)(p.B + o + 8 * q);
        in.kv[q] = *(const half8*)(p.K2 + o + 8 * q); in.vv[q] = *(const half8*)(p.V + o + 8 * q);
    }
}
__device__ __forceinline__ void subchunk_compute(const ScIn& in, char* L, int lane, f32x16 (&d6)[2], const Params& p, int hd, int tokn, ScIn& nxt) {
    const int r = lane & 31, h = lane >> 5;
    float xa[16];
    {
        const f32x4 (&w4)[4] = in.w4; const half8 (&av)[2] = in.av, (&rv)[2] = in.rv, (&bv)[2] = in.bv, (&kv)[2] = in.kv, (&vv)[2] = in.vv;
        float g[16];
        float acc = 0.f;
#pragma unroll
        for (int t = 0; t < 16; ++t) { acc += w4[t >> 2][t & 3]; g[t] = acc * 1.4426950408889634f; }
        const float rho = g[7], gC = g[15];
        const float ec = __builtin_amdgcn_exp2f(gC - rho);
        float erp = __builtin_amdgcn_exp2f(-rho);
#pragma unroll
        for (int tb = 0; tb < 2; ++tb) {
            half8 bh, kh, vt8;
#pragma unroll
            for (int tt = 0; tt < 8; ++tt) {
                const int t = tb * 8 + tt;
                const float ea = erp, er = __builtin_amdgcn_exp2f(g[t] - rho), eb = __builtin_amdgcn_exp2f(rho - g[t]), eh = eb * ec;
                erp = er;
                const float a_ = (float)av[tb][tt], r_ = (float)rv[tb][tt], b_ = (float)bv[tb][tt], k_ = (float)kv[tb][tt], v_ = (float)vv[tb][tt];
                xa[t] = a_ * ea;
                *(f16*)(L + SC_AR + t * 144 + lane * 2) = (f16)xa[t];
                *(f16*)(L + SC_AR + (16 + t) * 144 + lane * 2) = (f16)(r_ * er);
                *(f16*)(L + SC_BK + t * 144 + lane * 2) = (f16)(b_ * eb);
                *(f16*)(L + SC_BK + (16 + t) * 144 + lane * 2) = (f16)(k_ * eb);
                bh[tt] = (f16)(b_ * eh); kh[tt] = (f16)(k_ * eh); vt8[tt] = (f16)v_;
            }
            *(half8*)(L + SC_BH + lane * 32 + tb * 16) = bh;
            *(half8*)(L + SC_KH + lane * 32 + tb * 16) = kh;
            *(half8*)(L + SC_VT + lane * 32 + tb * 16) = vt8;
        }
        *(float*)(L + SC_GAM + lane * 4) = __builtin_amdgcn_exp2f(gC);
        *(float*)(L + SC_ERHO + lane * 4) = __builtin_amdgcn_exp2f(rho);
    }
    WAVE_LDS_SYNC();
    {
        f32x16 g1;
#pragma unroll
        for (int i = 0; i < 16; ++i) g1[i] = 0.f;
        half8 fa2[4], fb2[4];
#pragma unroll
        for (int s = 0; s < 4; ++s) { fa2[s] = *(const half8*)(L + SC_AR + r * 144 + (16 * s + 8 * h) * 2); fb2[s] = *(const half8*)(L + SC_BK + r * 144 + (16 * s + 8 * h) * 2); }
        __builtin_amdgcn_sched_barrier(0);
#pragma unroll
        for (int s = 0; s < 4; ++s) g1 = __builtin_amdgcn_mfma_f32_32x32x16_f16(fa2[s], fb2[s], g1, 0, 0, 0);
        const int col = r, ii = col & 15;
#pragma unroll
        for (int i = 0; i < 16; ++i) {
            const int row = (i & 3) + 8 * (i >> 2) + 4 * h, tt = row & 15;
            const bool keep = (row >= 16) ? (ii <= tt) : (ii < tt);
            const float val = keep ? g1[i] : 0.f;
            if (col < 16) {
                *(f16*)(L + SC_LB + row * 32 + col * 2) = (f16)val;
                if (row < 16) *(float*)(L + SC_LAB + (row * 16 + col) * 4) = val;
            } else {
                *(f16*)(L + SC_LK + row * 32 + (col - 16) * 2) = (f16)val;
            }
        }
    }
    WAVE_LDS_SYNC();
    {
        half8 fvt3[2], flk3;
        flk3 = *(const half8*)(L + SC_LK + r * 32 + h * 16);
#pragma unroll
        for (int vt = 0; vt < 2; ++vt) fvt3[vt] = *(const half8*)(L + SC_VT + (32 * vt + r) * 32 + h * 16);
        __builtin_amdgcn_sched_barrier(0);
#pragma unroll
        for (int vt = 0; vt < 2; ++vt) {
#pragma unroll
            for (int i = 0; i < 16; ++i) d6[vt][i] = 0.f;
            d6[vt] = __builtin_amdgcn_mfma_f32_32x32x16_f16(fvt3[vt], flk3, d6[vt], 0, 0, 0);
        }
    }
#pragma unroll
    for (int vt = 0; vt < 2; ++vt) {
        if (r < 16) {
#pragma unroll
            for (int g = 0; g < 4; ++g) {
                f32x4 w4; w4[0] = d6[vt][4 * g]; w4[1] = d6[vt][4 * g + 1]; w4[2] = d6[vt][4 * g + 2]; w4[3] = d6[vt][4 * g + 3];
                *(f32x4*)(L + SC_BK + (r * 68 + 32 * vt + 8 * g + 4 * h) * 4) = w4;
            }
        }
    }
    WAVE_LDS_SYNC();
    {
        float xu[16];
#pragma unroll
        for (int t = 0; t < 16; ++t) xu[t] = *(const float*)(L + SC_BK + (t * 68 + lane) * 4);
#pragma unroll
        for (int t = 1; t < 16; ++t) {
            float lrow[16];
            if ((t & 3) == 0) asm volatile("" ::: "memory");
#pragma unroll
            for (int q = 0; q < 4; ++q) { const f32x4 l4 = *(const f32x4*)(L + SC_LAB + (t * 16 + 4 * q) * 4); lrow[4 * q] = l4[0]; lrow[4 * q + 1] = l4[1]; lrow[4 * q + 2] = l4[2]; lrow[4 * q + 3] = l4[3]; }
#pragma unroll
            for (int i = 0; i < t; ++i) { xa[t] = fmaf(lrow[i], xa[i], xa[t]); xu[t] = fmaf(lrow[i], xu[i], xu[t]); }
        }
        const float erho = *(const float*)(L + SC_ERHO + lane * 4);
        half8 a0, a1, u0, u1;
#pragma unroll
        for (int t = 0; t < 8; ++t) { a0[t] = (f16)xa[t]; a1[t] = (f16)xa[t + 8]; u0[t] = (f16)xu[t]; u1[t] = (f16)xu[t + 8]; }
        *(half8*)(L + SC_AB + lane * 32) = a0; *(half8*)(L + SC_AB + lane * 32 + 16) = a1;
        *(half8*)(L + SC_UB + lane * 32) = u0; *(half8*)(L + SC_UB + lane * 32 + 16) = u1;
#pragma unroll
        for (int t = 0; t < 16; ++t) *(f16*)(L + SC_AR + t * 144 + lane * 2) = (f16)(xa[t] * erho);
    }
    WAVE_LDS_SYNC();
    {
        half8 fab[2], fub[2], flb;
        half4 rv[2][4]; f32x4 e4[2][4];
        flb = *(const half8*)(L + SC_LB + r * 32 + h * 16);
#pragma unroll
        for (int q = 0; q < 2; ++q) { fab[q] = *(const half8*)(L + SC_AB + (32 * q + r) * 32 + h * 16); fub[q] = *(const half8*)(L + SC_UB + (32 * q + r) * 32 + h * 16); }
#pragma unroll
        for (int kt = 0; kt < 2; ++kt)
#pragma unroll
            for (int g = 0; g < 4; ++g) {
                const int k0 = 32 * kt + 8 * g + 4 * h;
                rv[kt][g] = *(const half4*)(L + SC_AR + r * 144 + k0 * 2);
                e4[kt][g] = *(const f32x4*)(L + SC_ERHO + k0 * 4);
            }
        __builtin_amdgcn_sched_barrier(0);
        f32x16 d5[2];
#pragma unroll
        for (int kt = 0; kt < 2; ++kt) {
#pragma unroll
            for (int i = 0; i < 16; ++i) d5[kt][i] = 0.f;
            d5[kt] = __builtin_amdgcn_mfma_f32_32x32x16_f16(fab[kt], flb, d5[kt], 0, 0, 0);
        }
#pragma unroll
        for (int vt = 0; vt < 2; ++vt) d6[vt] = __builtin_amdgcn_mfma_f32_32x32x16_f16(fub[vt], flb, d6[vt], 0, 0, 0);
        if (r >= 16) {
#pragma unroll
            for (int kt = 0; kt < 2; ++kt)
#pragma unroll
                for (int g = 0; g < 4; ++g) {
                    const int k0 = 32 * kt + 8 * g + 4 * h;
                    half4 o;
#pragma unroll
                    for (int e = 0; e < 4; ++e) o[e] = (f16)(((float)rv[kt][g][e] + d5[kt][4 * g + e]) * e4[kt][g][e]);
                    *(half4*)(L + SC_AR + r * 144 + k0 * 2) = o;
                }
        }
    }
    subchunk_load(p, hd, tokn, lane, nxt);
    WAVE_LDS_SYNC();
}

template <bool WITH_IN>
__device__ __forceinline__ void subchunk_apply(char* L, const f32x16 (&d6)[2], f32x16 (&duy)[2], int lane, int sofs = SC_S16) {
    const int r = lane & 31, h = lane >> 5;
    {
        half8 fs[2][4], far[4];
#pragma unroll
        for (int s = 0; s < 4; ++s) {
            far[s] = *(const half8*)(L + SC_AR + r * 144 + (16 * s + 8 * h) * 2);
            fs[0][s] = *(const half8*)(L + sofs + r * 144 + (16 * s + 8 * h) * 2);
            fs[1][s] = *(const half8*)(L + sofs + (32 + r) * 144 + (16 * s + 8 * h) * 2);
        }
        __builtin_amdgcn_sched_barrier(0);
#pragma unroll
        for (int vt = 0; vt < 2; ++vt) {
            if (WITH_IN) duy[vt] = d6[vt];
            else {
#pragma unroll
                for (int i = 0; i < 16; ++i) duy[vt][i] = 0.f;
            }
        }
#pragma unroll
        for (int s = 0; s < 4; ++s)
#pragma unroll
            for (int vt = 0; vt < 2; ++vt) duy[vt] = __builtin_amdgcn_mfma_f32_32x32x16_f16(fs[vt][s], far[s], duy[vt], 0, 0, 0);
        if (r < 16) {
#pragma unroll
            for (int vt = 0; vt < 2; ++vt)
#pragma unroll
                for (int i = 0; i < 16; ++i) {
                    const int v = 32 * vt + (i & 3) + 8 * (i >> 2) + 4 * h;
                    *(f16*)(L + SC_UB + v * 32 + r * 2) = (f16)duy[vt][i];
                }
        }
    }
    WAVE_LDS_SYNC();
    {
        half8 fu[2], fv[2];
#pragma unroll
        for (int q = 0; q < 2; ++q) {
            fu[q] = *(const half8*)(L + SC_UB + (32 * q + r) * 32 + h * 16);
            if (WITH_IN) fv[q] = *(const half8*)(L + SC_VT + (32 * q + r) * 32 + h * 16);
        }
#pragma unroll
        for (int kt = 0; kt < 2; ++kt) {
            f32x4 gmv[4]; half4 svv[2][4]; half8 fbh, fkh;
#pragma unroll
            for (int g = 0; g < 4; ++g) {
                gmv[g] = *(const f32x4*)(L + SC_GAM + (32 * kt + 8 * g + 4 * h) * 4);
#pragma unroll
                for (int vt = 0; vt < 2; ++vt) svv[vt][g] = *(const half4*)(L + sofs + (32 * vt + r) * 144 + (32 * kt + 4 * h) * 2 + 16 * g);
            }
            fbh = *(const half8*)(L + SC_BH + (32 * kt + r) * 32 + h * 16);
            if (WITH_IN) fkh = *(const half8*)(L + SC_KH + (32 * kt + r) * 32 + h * 16);
            __builtin_amdgcn_sched_barrier(0);
            f32x16 acc[2];
#pragma unroll
            for (int vt = 0; vt < 2; ++vt)
#pragma unroll
                for (int g = 0; g < 4; ++g)
#pragma unroll
                    for (int e = 0; e < 4; ++e) acc[vt][4 * g + e] = (float)svv[vt][g][e] * gmv[g][e];
#pragma unroll
            for (int vt = 0; vt < 2; ++vt) acc[vt] = __builtin_amdgcn_mfma_f32_32x32x16_f16(fbh, fu[vt], acc[vt], 0, 0, 0);
            if (WITH_IN) {
#pragma unroll
                for (int vt = 0; vt < 2; ++vt) acc[vt] = __builtin_amdgcn_mfma_f32_32x32x16_f16(fkh, fv[vt], acc[vt], 0, 0, 0);
            }
#pragma unroll
            for (int vt = 0; vt < 2; ++vt)
#pragma unroll
                for (int g = 0; g < 4; ++g) {
                    half4 o;
#pragma unroll
                    for (int e = 0; e < 4; ++e) o[e] = (f16)acc[vt][4 * g + e];
                    *(half4*)(L + sofs + (32 * vt + r) * 144 + (32 * kt + 4 * h) * 2 + 16 * g) = o;
                }
        }
    }
    WAVE_LDS_SYNC();
}

__device__ __forceinline__ void side_cvt_wdn(const Params& p, int sw, int nsw, int lane, size_t q0, size_t q1) {
    const size_t stride = (size_t)nsw * 64;
    size_t i = q0 + (size_t)sw * 64 + lane;
    for (; i + 7 * stride < q1; i += 8 * stride) {
        f32x4 v[8];
#pragma unroll
        for (int j = 0; j < 8; ++j) v[j] = __builtin_nontemporal_load((const f32x4*)p.w_dn + i + j * stride);
#pragma unroll
        for (int j = 0; j < 8; ++j) { half4 o; o[0] = (f16)v[j][0]; o[1] = (f16)v[j][1]; o[2] = (f16)v[j][2]; o[3] = (f16)v[j][3]; *((half4*)p.Wdn16 + i + j * stride) = o; }
    }
    for (; i < q1; i += stride) {
        const f32x4 v = __builtin_nontemporal_load((const f32x4*)p.w_dn + i);
        half4 o; o[0] = (f16)v[0]; o[1] = (f16)v[1]; o[2] = (f16)v[2]; o[3] = (f16)v[3]; *((half4*)p.Wdn16 + i) = o;
    }
}
__device__ __forceinline__ void side_rope(const Params& p, int sw, int nsw, int lane) {
    const int j = lane & 31, hb = lane >> 5;
    for (int t = sw; t < T_; t += nsw) {
        const float cs = p.ropec[t * 32 + j], sn = p.ropes[t * 32 + j];
        f16 a1[10], a2[10];
#pragma unroll
        for (int it = 0; it < 10; ++it) {
            const f16* src = p.P + (size_t)t * NINP + C_AQ + (2 * it + hb) * 64 + j;
            a1[it] = src[0]; a2[it] = src[32];
        }
        asm volatile("" ::: "memory");
#pragma unroll
        for (int it = 0; it < 10; ++it) {
            const float x1 = (float)a1[it], x2 = (float)a2[it];
            if (it < 8) {
                const int hd = 2 * it + hb;
                p.qr[(size_t)t * 1024 + hd * 64 + j] = (f16)((x1 * cs - x2 * sn) * 0.125f);
                p.qr[(size_t)t * 1024 + hd * 64 + 32 + j] = (f16)((x2 * cs + x1 * sn) * 0.125f);
            } else {
                const int kh = 2 * (it - 8) + hb;
                p.kr[(size_t)t * 256 + kh * 64 + j] = (f16)(x1 * cs - x2 * sn);
                p.kr[(size_t)t * 256 + kh * 64 + 32 + j] = (f16)(x2 * cs + x1 * sn);
            }
        }
    }
}
#define WDN_Q4 ((size_t)NEXP * DE * D_ / 4)
#define WDN_SPLIT (WDN_Q4 * 3 / 5)

__device__ __forceinline__ void phase_rwkv1(const Params& p, char* smem) {
    const int tid = phase_tid(), lane = tid & 63, wid = tid >> 6;
    if (wid >= 4) { const int sw = blockIdx.x * 4 + (wid - 4), nsw = gridDim.x * 4; side_rope(p, sw, nsw, lane); return; }
    char* L = smem + wid * SC_BYTES;
    for (int unit = blockIdx.x * 4 + wid; unit < NH * NCHK; unit += gridDim.x * 4) {
        const int hd = unit / NCHK, c = unit % NCHK;
        {
            const half8 z = {0, 0, 0, 0, 0, 0, 0, 0};
#pragma unroll
            for (int q = 0; q < 8; ++q) { *(half8*)(L + SC_S16 + lane * 144 + q * 16) = z; *(half8*)(L + SC_S16B + lane * 144 + q * 16) = z; }
            *(f16*)(L + SC_S16B + lane * 144 + lane * 2) = (f16)1.f;
        }
        WAVE_LDS_SYNC();
        ScIn cur; subchunk_load(p, hd, c * CHS * 16, lane, cur);
        for (int s = 0; s < CHS; ++s) {
            f32x16 d6[2], duy[2];
            ScIn nxt;
            subchunk_compute(cur, L, lane, d6, p, hd, (c * CHS + (s + 1 < CHS ? s + 1 : s)) * 16, nxt);
            subchunk_apply<true>(L, d6, duy, lane, SC_S16);
            subchunk_apply<false>(L, d6, duy, lane, SC_S16B);
            cur = nxt;
        }
        const size_t base = (size_t)(hd * NCHK + c) * 4096;
#pragma unroll
        for (int q = 0; q < 8; ++q) *(half8*)(p.segQ + base + lane * 64 + q * 8) = *(const half8*)(L + SC_S16 + lane * 144 + q * 16);
#pragma unroll 8
        for (int k = 0; k < 64; ++k) p.PT[base + k * 64 + lane] = *(const f16*)(L + SC_S16B + lane * 144 + k * 2);
        WAVE_LDS_SYNC();
    }
}

#define PF2 8
#define R2_SLOT 27648
__device__ __forceinline__ void phase_rwkv2_head(const Params& p, char* smem, int hd) {
    const int tid = phase_tid(), lane = tid & 63, r = lane & 31, h = lane >> 5;
    const int wid = __builtin_amdgcn_readfirstlane(tid >> 6);
    const int crow = tid >> 3, cch = tid & 7;
    const int loff = crow * 144 + cch * 16;
    f32x16 acc[2];
#pragma unroll
    for (int kt = 0; kt < 2; ++kt)
#pragma unroll
        for (int i = 0; i < 16; ++i) acc[kt][i] = 0.f;
    u32x4 pn[PF2], qn[PF2];
    const f16* PTh = p.PT + (size_t)hd * NCHK * 4096 + crow * 64 + cch * 8;
    const f16* Qh = p.segQ + (size_t)hd * NCHK * 4096 + crow * 64 + cch * 8;
    f16* Sh = p.Sst + (size_t)hd * NCHK * 4096 + crow * 64 + cch * 8;
#pragma unroll
    for (int j = 0; j < PF2; ++j) { pn[j] = *(const u32x4*)(PTh + (size_t)j * 4096); qn[j] = *(const u32x4*)(Qh + (size_t)j * 4096); }
    __syncthreads();
#pragma unroll
    for (int j = 0; j < 2; ++j) {
        *(u32x4*)(smem + j * R2_SLOT + loff) = pn[j]; *(u32x4*)(smem + j * R2_SLOT + 9216 + loff) = qn[j];
        pn[j] = *(const u32x4*)(PTh + (size_t)(PF2 + j) * 4096); qn[j] = *(const u32x4*)(Qh + (size_t)(PF2 + j) * 4096);
    }
    asm volatile("s_waitcnt lgkmcnt(0)" ::: "memory");
    __builtin_amdgcn_s_barrier();
    asm volatile("" ::: "memory");
    for (int c0 = 0; c0 < NCHK; c0 += PF2) {
#pragma unroll
        for (int j = 0; j < PF2; ++j) {
            const int c = c0 + j, jj = (j + 2) & (PF2 - 1);
            if (wid < 2) {
                const char* Sl = smem + (j & 3) * R2_SLOT;
                half4 pf[2][4][2];
#pragma unroll
                for (int kt = 0; kt < 2; ++kt)
#pragma unroll
                    for (int ks = 0; ks < 4; ++ks) {
                        pf[kt][ks][0] = *(const half4*)(Sl + (32 * kt + r) * 144 + (16 * ks + 4 * h) * 2);
                        pf[kt][ks][1] = *(const half4*)(Sl + (32 * kt + r) * 144 + (16 * ks + 8 + 4 * h) * 2);
                    }
                f32x16 an[2];
#pragma unroll
                for (int kt = 0; kt < 2; ++kt)
#pragma unroll
                    for (int g = 0; g < 4; ++g) {
                        const half4 qv = *(const half4*)(Sl + 9216 + (32 * wid + r) * 144 + (32 * kt + 8 * g + 4 * h) * 2);
                        an[kt][4 * g] = (float)qv[0]; an[kt][4 * g + 1] = (float)qv[1]; an[kt][4 * g + 2] = (float)qv[2]; an[kt][4 * g + 3] = (float)qv[3];
                    }
                half8 sf[4];
#pragma unroll
                for (int ks = 0; ks < 4; ++ks)
#pragma unroll
                    for (int e = 0; e < 8; ++e) sf[ks][e] = (f16)acc[ks >> 1][8 * (ks & 1) + e];
#pragma unroll
                for (int ks = 0; ks < 4; ++ks) {
                    half4 lo, hi;
#pragma unroll
                    for (int e = 0; e < 4; ++e) { lo[e] = sf[ks][e]; hi[e] = sf[ks][4 + e]; }
                    *(half4*)(const_cast<char*>(Sl) + 18432 + (32 * wid + r) * 144 + (16 * ks + 4 * h) * 2) = lo;
                    *(half4*)(const_cast<char*>(Sl) + 18432 + (32 * wid + r) * 144 + (16 * ks + 8 + 4 * h) * 2) = hi;
                }
#pragma unroll
                for (int ks = 0; ks < 4; ++ks)
#pragma unroll
                    for (int kt = 0; kt < 2; ++kt) {
                        half8 af;
#pragma unroll
                        for (int e = 0; e < 4; ++e) { af[e] = pf[kt][ks][0][e]; af[4 + e] = pf[kt][ks][1][e]; }
                        an[kt] = __builtin_amdgcn_mfma_f32_32x32x16_f16(af, sf[ks], an[kt], 0, 0, 0);
                    }
                acc[0] = an[0]; acc[1] = an[1];
            }
            {
                char* Sw = smem + ((j + 2) & 3) * R2_SLOT;
                *(u32x4*)(Sw + loff) = pn[jj]; *(u32x4*)(Sw + 9216 + loff) = qn[jj];
                const int cn = (c + 2 + PF2 < NCHK) ? (c + 2 + PF2) : (NCHK - 1);
                pn[jj] = *(const u32x4*)(PTh + (size_t)cn * 4096); qn[jj] = *(const u32x4*)(Qh + (size_t)cn * 4096);
            }
            {
                const int cm = c > 0 ? c - 1 : 0;
                *(u32x4*)(Sh + (size_t)cm * 4096) = *(const u32x4*)(smem + ((j + 3) & 3) * R2_SLOT + 18432 + loff);
            }
            asm volatile("s_waitcnt lgkmcnt(0)" ::: "memory");
            __builtin_amdgcn_s_barrier();
            asm volatile("" ::: "memory");
        }
    }
    *(u32x4*)(Sh + (size_t)(NCHK - 1) * 4096) = *(const u32x4*)(smem + ((NCHK - 1) & 3) * R2_SLOT + 18432 + loff);
}

__device__ __forceinline__ void phase_rwkv3(const Params& p, char* smem) {
    const int tid = phase_tid(), lane0 = tid & 63, wid = tid >> 6;
    if (wid >= 4) return;
    char* L = smem + wid * SC_BYTES;
    for (int unit = blockIdx.x * 4 + wid; unit < NH * NCHK; unit += gridDim.x * 4) {
        const int hd = unit / NCHK, c = unit % NCHK;
        const size_t base = (size_t)(hd * NCHK + c) * 4096;
        int lu = lane0; asm volatile("" : "+v"(lu));
#pragma unroll
        for (int q = 0; q < 8; ++q) *(half8*)(L + SC_S16 + lu * 144 + q * 16) = *(const half8*)(p.Sst + base + lu * 64 + q * 8);
        WAVE_LDS_SYNC();
        ((float*)(L + SC_S16B))[lu] = p.gn_w[hd * 64 + lu]; ((float*)(L + SC_S16B))[64 + lu] = p.gn_b[hd * 64 + lu];
        ScIn cur; subchunk_load(p, hd, c * CHS * 16, lu, cur);
        for (int s = 0; s < CHS; ++s) {
            f32x16 d6[2], duy[2];
            const int tok0 = (c * CHS + s) * 16;
            ScIn nxt;
            int lane = lane0; asm volatile("" : "+v"(lane));
            const int r = lane & 31, h = lane >> 5;
            const int te = tok0 + (r >= 16 ? r - 16 : 0);
            half4 ggv[2][4];
#pragma unroll
            for (int vt = 0; vt < 2; ++vt)
#pragma unroll
                for (int g = 0; g < 4; ++g) ggv[vt][g] = *(const half4*)(p.G + (size_t)te * RW + hd * 64 + 32 * vt + 8 * g + 4 * h);
            const float bon = p.bonus[te * NH + hd];
            subchunk_compute(cur, L, lane, d6, p, hd, (c * CHS + (s + 1 < CHS ? s + 1 : s)) * 16, nxt);
            subchunk_apply<true>(L, d6, duy, lane);
            cur = nxt;
            float sum = 0.f;
#pragma unroll
            for (int vt = 0; vt < 2; ++vt)
#pragma unroll
                for (int i = 0; i < 16; ++i) sum += duy[vt][i];
            sum += __shfl_xor(sum, 32);
            const float mean = sum * (1.0f / 64.0f);
            float sq = 0.f;
#pragma unroll
            for (int vt = 0; vt < 2; ++vt)
#pragma unroll
                for (int i = 0; i < 16; ++i) { const float d = duy[vt][i] - mean; sq += d * d; }
            sq += __shfl_xor(sq, 32);
            const float rstd = 1.0f / sqrtf(sq * (1.0f / 64.0f) + 64e-5f);
            if (r >= 16) {
                const int tl = r - 16, t = tok0 + tl;
#pragma unroll
                for (int vt = 0; vt < 2; ++vt)
#pragma unroll
                    for (int g = 0; g < 4; ++g) {
                        const int v0 = 32 * vt + 8 * g + 4 * h, ch = hd * 64 + v0;
                        const f32x4 gw = *(const f32x4*)(L + SC_S16B + v0 * 4), gb = *(const f32x4*)(L + SC_S16B + 256 + v0 * 4);
                        const half4 gg = ggv[vt][g];
                        half4 o;
#pragma unroll
                        for (int e = 0; e < 4; ++e) {
                            const float vv = (float)*(const f16*)(L + SC_VT + (v0 + e) * 32 + tl * 2);
                            const float yn = (duy[vt][4 * g + e] - mean) * rstd * gw[e] + gb[e] + bon * vv;
                            o[e] = (f16)(yn * (float)gg[e]);
                        }
                        *(half4*)(p.ycat + (size_t)t * D_ + ch) = o;
                    }
            }
        }
    }
}
#define KS_STRIDE 144
#define VT_STRIDE 544
__device__ __forceinline__ void phase_attn(const Params& p, char* smem) {
    const int tid = phase_tid(), lane = tid & 63, wid = tid >> 6, r = lane & 31, h = lane >> 5;
    char* Ks = smem; char* Vt = smem + 256 * KS_STRIDE;
    volatile int* slot = (volatile int*)(smem + 143360);
    for (;;) {
        __syncthreads();
        if (tid == 0) *slot = (int)atomicAdd(&p.bar[10240], 1u);
        __syncthreads();
        const int u = *slot;
        if (u >= 64 * 4) break;
        const int qb = u >> 2, kvh = u & 3, t0 = qb * 128;
        __syncthreads();
        u32x4 kv4[4]; half8 vv4[4];
#pragma unroll
        for (int i = 0; i < 4; ++i) {
            const int c = tid + NTHR * i, key = c >> 3, cc = c & 7, tk = t0 - 128 + key, tkc = tk < 0 ? 0 : tk;
            kv4[i] = *(const u32x4*)(p.kr + (size_t)tkc * 256 + kvh * 64 + cc * 8);
            vv4[i] = *(const half8*)(p.P + (size_t)tkc * NINP + C_AV + kvh * 64 + cc * 8);
        }
        asm volatile("" ::: "memory");
#pragma unroll
        for (int i = 0; i < 4; ++i) {
            const int c = tid + NTHR * i, key = c >> 3, cc = c & 7, tk = t0 - 128 + key;
            u32x4 kv = kv4[i]; half8 vv = vv4[i];
            if (tk < 0) { kv[0] = 0u; kv[1] = 0u; kv[2] = 0u; kv[3] = 0u; vv = half8{0, 0, 0, 0, 0, 0, 0, 0}; }
            *(u32x4*)(Ks + key * KS_STRIDE + cc * 16) = kv;
#pragma unroll
            for (int e = 0; e < 8; ++e) *(f16*)(Vt + (cc * 8 + e) * VT_STRIDE + cc * 8 + key * 2) = vv[e];
        }
        __syncthreads();
        const int qh = kvh * 4 + (wid >> 1);
        const float sink = p.sinks[qh];
        for (int sub = 0; sub < 2; ++sub) {
            const int q0 = (wid & 1) * 64 + sub * 32;
            half8 qf[4];
#pragma unroll
            for (int s = 0; s < 4; ++s) qf[s] = *(const half8*)(p.qr + (size_t)(t0 + q0 + r) * 1024 + qh * 64 + 16 * s + 8 * h);
            const int qs = q0 >> 5;
            f32x16 sc[5];
#pragma unroll
            for (int mi = 0; mi < 5; ++mi) {
#pragma unroll
                for (int i = 0; i < 16; ++i) sc[mi][i] = 0.f;
#pragma unroll
                for (int s = 0; s < 4; ++s) {
                    const half8 kf = *(const half8*)(Ks + (32 * (qs + mi) + r) * KS_STRIDE + (16 * s + 8 * h) * 2);
                    sc[mi] = __builtin_amdgcn_mfma_f32_32x32x16_f16(kf, qf[s], sc[mi], 0, 0, 0);
                }
            }
            const int qrel = q0 + r;
            float mx = sink;
#pragma unroll
            for (int mi = 0; mi < 5; ++mi)
#pragma unroll
                for (int i = 0; i < 16; ++i) {
                    const int key = 32 * (qs + mi) + (i & 3) + 8 * (i >> 2) + 4 * h;
                    const int rel = qrel + 128 - key;
                    const bool ok = (rel >= 0) && (rel < 128) && (qb > 0 || key >= 128);
                    sc[mi][i] = ok ? sc[mi][i] : -INFINITY;
                    mx = fmaxf(mx, sc[mi][i]);
                }
            mx = fmaxf(mx, __shfl_xor(mx, 32));
            float den = 0.f;
#pragma unroll
            for (int mi = 0; mi < 5; ++mi)
#pragma unroll
                for (int i = 0; i < 16; ++i) { const float e = __expf(sc[mi][i] - mx); sc[mi][i] = e; den += e; }
            den += __shfl_xor(den, 32);
            den += __expf(sink - mx);
            const float inv = 1.0f / den;
            f32x16 o0, o1;
#pragma unroll
            for (int i = 0; i < 16; ++i) { o0[i] = 0.f; o1[i] = 0.f; }
#pragma unroll
            for (int mi = 0; mi < 5; ++mi)
#pragma unroll
                for (int s = 0; s < 2; ++s) {
                    half8 pf;
#pragma unroll
                    for (int j = 0; j < 8; ++j) pf[j] = (f16)(sc[mi][8 * s + j] * inv);
                    const int kb = 32 * (qs + mi) + 16 * s + 4 * h;
                    half8 v0, v1;
                    {
                        const half4 lo = *(const half4*)(Vt + r * VT_STRIDE + (r >> 3) * 8 + kb * 2), hi = *(const half4*)(Vt + r * VT_STRIDE + (r >> 3) * 8 + (kb + 8) * 2);
                        v0[0] = lo[0]; v0[1] = lo[1]; v0[2] = lo[2]; v0[3] = lo[3]; v0[4] = hi[0]; v0[5] = hi[1]; v0[6] = hi[2]; v0[7] = hi[3];
                    }
                    {
                        const half4 lo = *(const half4*)(Vt + (32 + r) * VT_STRIDE + (4 + (r >> 3)) * 8 + kb * 2), hi = *(const half4*)(Vt + (32 + r) * VT_STRIDE + (4 + (r >> 3)) * 8 + (kb + 8) * 2);
                        v1[0] = lo[0]; v1[1] = lo[1]; v1[2] = lo[2]; v1[3] = lo[3]; v1[4] = hi[0]; v1[5] = hi[1]; v1[6] = hi[2]; v1[7] = hi[3];
                    }
                    o0 = __builtin_amdgcn_mfma_f32_32x32x16_f16(v0, pf, o0, 0, 0, 0);
                    o1 = __builtin_amdgcn_mfma_f32_32x32x16_f16(v1, pf, o1, 0, 0, 0);
                }
            f16* orow = p.ycat + (size_t)(t0 + q0 + r) * D_ + RW + qh * 64;
#pragma unroll
            for (int g = 0; g < 4; ++g) {
                half4 a, b;
#pragma unroll
                for (int e = 0; e < 4; ++e) { a[e] = (f16)o0[4 * g + e]; b[e] = (f16)o1[4 * g + e]; }
                *(half4*)(orow + 8 * g + 4 * h) = a;
                *(half4*)(orow + 32 + 8 * g + 4 * h) = b;
            }
        }
    }
}

__device__ __forceinline__ void phase_outproj(const Params& p, char* smem, int cwg) {
    pg8::Gemm g; g.A = (const pg8::bf16_t*)p.ycat; g.Bt = (const pg8::bf16_t*)p.WoutT; g.M = T_; g.N = D_; g.K = D_;
    pg8::StaticOrder so; so.init(T_, D_, gridDim.x, cwg);
    pg8::EpiResidualF32 e; e.C = p.x1; e.base = p.x; e.ldc = D_;
    pg8::gemm_phase<pg8::EpiResidualF32, pg8::StaticOrder, false>((PG8_LAS unsigned char*)smem, g, so, e, nullptr);
}

__device__ __forceinline__ float router_w(const Params& p, int k, int c) {
    if (c < 8) return p.w_rg[k * 8 + c];
    if (c < 72) return p.w_re[k * 64 + (c - 8)];
    return 0.f;
}
__device__ __forceinline__ void phase_router(const Params& p, char* smem) {
    const int tid = phase_tid(), lane = tid & 63, wid = tid >> 6, i32 = lane & 31, kk = lane >> 5;
    float* part = (float*)smem;
    float* ssq = part + 8 * 3 * 16 * 64;
    float* logit = ssq + 2 * NTHR;
    float* rstd_s = logit + 32 * 72;
    for (int u = blockIdx.x; u < T_ / 32; u += gridDim.x) {
        const int t0 = u * 32;
        f32x16 acc[3], acx[3];
#pragma unroll
        for (int j = 0; j < 3; ++j)
#pragma unroll
            for (int i = 0; i < 16; ++i) { acc[j][i] = 0.f; acx[j][i] = 0.f; }
        float ss0 = 0.f, ss1 = 0.f;
        char* XH = smem; char* XL = smem + 8704; char* WH = smem + 17408; char* WL = smem + 17408 + 26112;
        f32x4 xv[2], gv[2]; u32x4 wh[3], wl[3];
#define RT_LOAD(kc) do { _Pragma("unroll") for (int q = 0; q < 2; ++q) { const int idx = tid + NTHR * q, row = idx >> 5, c4 = idx & 31; \
            xv[q] = *(const f32x4*)(p.x1 + (size_t)(t0 + row) * D_ + (kc) + 4 * c4); gv[q] = *(const f32x4*)(p.ln2 + (kc) + 4 * c4); } \
        _Pragma("unroll") for (int q = 0; q < 3; ++q) { const int idx = tid + NTHR * q, row = idx >> 4, cc = idx & 15; \
            wh[q] = *(const u32x4*)(p.WrH + (size_t)row * D_ + (kc) + 8 * cc); wl[q] = *(const u32x4*)(p.WrL + (size_t)row * D_ + (kc) + 8 * cc); } } while (0)
        RT_LOAD(0);
        for (int kc = 0; kc < D_; kc += 128) {
            __syncthreads();
#pragma unroll
            for (int q = 0; q < 2; ++q) {
                const int idx = tid + NTHR * q, row = idx >> 5, c4 = idx & 31;
                half4 hi, lo; float s2 = 0.f;
#pragma unroll
                for (int e = 0; e < 4; ++e) {
                    s2 += xv[q][e] * xv[q][e];
                    const float a_ = xv[q][e] * gv[q][e];
                    hi[e] = (f16)a_; lo[e] = (f16)((a_ - (float)hi[e]) * 2048.0f);
                }
                if (q == 0) ss0 += s2; else ss1 += s2;
                *(half4*)(XH + row * 272 + c4 * 8) = hi; *(half4*)(XL + row * 272 + c4 * 8) = lo;
                *(half4*)(p.xm + (size_t)(t0 + row) * D_ + kc + 4 * c4) = hi;
            }
#pragma unroll
            for (int q = 0; q < 3; ++q) {
                const int idx = tid + NTHR * q, row = idx >> 4, cc = idx & 15;
                *(u32x4*)(WH + row * 272 + cc * 16) = wh[q]; *(u32x4*)(WL + row * 272 + cc * 16) = wl[q];
            }
            __syncthreads();
            if (kc + 128 < D_) RT_LOAD(kc + 128);
            {
                const int ko = (16 * wid + 8 * kk) * 2;
                const half8 ah = *(const half8*)(XH + i32 * 272 + ko), al = *(const half8*)(XL + i32 * 272 + ko);
#pragma unroll
                for (int j = 0; j < 3; ++j) {
                    const half8 bh = *(const half8*)(WH + (32 * j + i32) * 272 + ko), bl = *(const half8*)(WL + (32 * j + i32) * 272 + ko);
                    acc[j] = __builtin_amdgcn_mfma_f32_32x32x16_f16(ah, bh, acc[j], 0, 0, 0);
                    acx[j] = __builtin_amdgcn_mfma_f32_32x32x16_f16(ah, bl, acx[j], 0, 0, 0);
                    acx[j] = __builtin_amdgcn_mfma_f32_32x32x16_f16(al, bh, acx[j], 0, 0, 0);
                }
            }
        }
#undef RT_LOAD
#pragma unroll
        for (int j = 0; j < 3; ++j)
#pragma unroll
            for (int i = 0; i < 16; ++i) acc[j][i] += acx[j][i] * (1.0f / 2048.0f);
        __syncthreads();
#pragma unroll
        for (int j = 0; j < 3; ++j)
#pragma unroll
            for (int i = 0; i < 16; ++i) part[((wid * 3 + j) * 16 + i) * 64 + lane] = acc[j][i];
        ssq[tid] = ss0; ssq[NTHR + tid] = ss1;
        __syncthreads();
        if (tid < 32) {
            float s = 0.f;
            const float* sr = ssq + (tid >> 4) * NTHR + (tid & 15) * 32;
#pragma unroll
            for (int w = 0; w < 32; ++w) s += sr[w];
            const float rs = 1.0f / sqrtf(s * (1.0f / D_) + 1e-6f);
            rstd_s[tid] = rs; p.rstd2[t0 + tid] = rs;
        }
        __syncthreads();
        for (int idx = tid; idx < 32 * 72; idx += NTHR) {
            const int tok = idx / 72, c = idx % 72, j = c >> 5, col = c & 31;
            const int hh = (tok >> 2) & 1, reg = (tok & 3) + 4 * (tok >> 3), ln = col + 32 * hh;
            float s = 0.f;
#pragma unroll
            for (int w = 0; w < 8; ++w) s += part[((w * 3 + j) * 16 + reg) * 64 + ln];
            logit[tok * 72 + c] = s * rstd_s[tok] + (c < 8 ? p.b_rg[c] : p.b_re[c - 8]);
        }
        __syncthreads();
        if (tid < 32) {
            const float* lg = logit + tid * 72;
            int gi = 0; float gm = lg[0];
#pragma unroll
            for (int g = 1; g < 8; ++g) if (lg[g] > gm) { gm = lg[g]; gi = g; }
            float se = 0.f;
#pragma unroll
            for (int g = 0; g < 8; ++g) se += expf(lg[g] - gm);
            const float pg = 1.0f / se;
            const float* el = lg + 8 + gi * 8;
            int e0 = 0; float v0 = el[0];
#pragma unroll
            for (int j = 1; j < 8; ++j) if (el[j] > v0) { v0 = el[j]; e0 = j; }
            int e1 = -1; float v1 = -INFINITY;
#pragma unroll
            for (int j = 0; j < 8; ++j) if (j != e0 && el[j] > v1) { v1 = el[j]; e1 = j; }
            const float w1 = 1.0f / (1.0f + expf(v0 - v1)), w0 = 1.0f - w1;
            const int t = t0 + tid;
            p.eid[2 * t] = gi * 8 + e0; p.eid[2 * t + 1] = gi * 8 + e1;
            p.gate[2 * t] = pg * w0; p.gate[2 * t + 1] = pg * w1;
        }
        __syncthreads();
    }
}

__device__ __forceinline__ void phase_lists(const Params& p, char* smem) {
    int* wtab = (int*)smem;
    const int tid = phase_tid(), lane = tid & 63, wid = tid >> 6;
    for (int e = blockIdx.x; e < NEXP; e += gridDim.x) {
        int ev[32];
#pragma unroll
        for (int it = 0; it < 32; ++it) ev[it] = p.eid[it * NTHR + tid];
        __syncthreads();
#pragma unroll
        for (int it = 0; it < 32; ++it) {
            const unsigned long long m = __ballot(ev[it] == e);
            if (lane == 0) wtab[it * 8 + wid] = __popcll(m);
        }
        __syncthreads();
        if (wid == 0) {
            int c0 = wtab[4 * lane], c1 = wtab[4 * lane + 1], c2 = wtab[4 * lane + 2], c3 = wtab[4 * lane + 3];
            const int tot4 = c0 + c1 + c2 + c3;
            int inc = tot4;
#pragma unroll
            for (int o = 1; o < 64; o <<= 1) { const int t = __shfl_up(inc, o); if (lane >= o) inc += t; }
            const int ex = inc - tot4;
            wtab[4 * lane] = ex; wtab[4 * lane + 1] = ex + c0; wtab[4 * lane + 2] = ex + c0 + c1; wtab[4 * lane + 3] = ex + c0 + c1 + c2;
            if (lane == 63) { wtab[256] = inc; p.cnt[e] = inc; }
        }
        __syncthreads();
#pragma unroll
        for (int it = 0; it < 32; ++it) {
            const bool f = ev[it] == e;
            const unsigned long long m = __ballot(f);
            if (f) p.list[e * T_ + wtab[it * 8 + wid] + __popcll(m & ((1ull << lane) - 1ull))] = it * NTHR + tid;
        }
    }
}

__device__ __forceinline__ float silu_f(float v) { return v / (1.0f + __expf(-v)); }
#define MOE_A_BYTES (384 * 144)
#define MOE_BUF (MOE_A_BYTES + 128 * 144)
#define MOE_TAB (2 * MOE_BUF)
#define MOE_SLOT (MOE_TAB + 1024)

__device__ __forceinline__ void moe_tables(const Params& p, int* tab) {
    __syncthreads();
    if (threadIdx.x < NEXP) {
        const int e = threadIdx.x, c = p.cnt[e];
        const int tl = c <= 256 ? (c > 0 ? 1 : 0) : (c + 383) / 384;
        int a = tl, b = c;
#pragma unroll
        for (int o = 1; o < 64; o <<= 1) { const int ta = __shfl_up(a, o), tb = __shfl_up(b, o); if (e >= o) { a += ta; b += tb; } }
        tab[e] = a - tl; tab[65 + e] = b - c;
        if (e == NEXP - 1) { tab[64] = a; tab[129] = b; }
    }
    __syncthreads();
}

template <bool IS_GU, int MI>
__device__ __forceinline__ void moe_unit(const Params& p, char* smem, int tid, int e, int nt, int mt, int cnt, int rowoff, const int* lst) {
    constexpr int K = IS_GU ? D_ : DE, NK = K / 64, LDW = IS_GU ? 2 * DE : D_, RT = 128 * MI, NA = 2 * MI;
    const int lane = tid & 63, wid = tid >> 6, wm = wid >> 1, wn = wid & 1, r = lane & 31, h = lane >> 5;
    const int kgB = (wid >> 1) * 4 + ((lane >> 2) & 3), ngl = (lane & 3) | ((lane >> 4) << 2), nB = 64 * (wid & 1) + 4 * ngl;
    const f16* abase = IS_GU ? p.xm : p.Hbuf + (size_t)rowoff * DE;
    const int nch = __builtin_amdgcn_readfirstlane((min(cnt - mt * RT, RT) + 63) >> 6);
    unsigned aofs[NA];
    const int aoff0 = (tid >> 3) * 144 + (tid & 7) * 16;
#pragma unroll
    for (int i = 0; i < NA; ++i) {
        const int c = tid + NTHR * i, row = c >> 3, cc = c & 7;
        int grow = mt * RT + row; if (grow >= cnt) grow = cnt - 1;
        if (IS_GU) aofs[i] = (unsigned)(lst[grow] >> 1) * D_ + cc * 8;
        else aofs[i] = (unsigned)grow * DE + cc * 8;
    }
    const float* wB;
    if constexpr (IS_GU) wB = p.w_gu + (size_t)e * D_ * (2 * DE) + (ngl >> 3) * DE + nt * 64 + 32 * (wid & 1) + 4 * (ngl & 7);
    else wB = p.w_dn + (size_t)e * DE * D_ + nt * 128 + nB;
    wB += (size_t)(4 * kgB) * LDW;
    int boff[4];
#pragma unroll
    for (int ni = 0; ni < 4; ++ni) boff[ni] = MOE_A_BYTES + (nB + ni) * 144 + kgB * 8;
    f32x16 acc[MI][2];
#pragma unroll
    for (int mi = 0; mi < MI; ++mi)
#pragma unroll
        for (int j = 0; j < 2; ++j)
#pragma unroll
            for (int i = 0; i < 16; ++i) acc[mi][j][i] = 0.f;
    constexpr int DA = 2, DB = 2;
    u32x4 ra[DA][NA]; f32x4 rb[DB][4];
    const int afrag = (32 * MI * wm + r) * 144 + h * 16, bfrag = MOE_A_BYTES + (64 * wn + r) * 144 + h * 16;
#define MOE_LOADA(set, kt) do { _Pragma("unroll") for (int i = 0; i < NA; ++i) if (i < NA - 2 || i < nch) ra[set][i] = *(const u32x4*)(abase + aofs[i] + (kt) * 64); } while (0)
#define MOE_LOADB(set, kt) do { _Pragma("unroll") for (int j = 0; j < 4; ++j) rb[set][j] = *(const f32x4*)(wB + (size_t)((kt) * 64 + j) * LDW); } while (0)
#define MOE_WRITE(seta, setb, buf) do { char* Lb = smem + (buf) * MOE_BUF; _Pragma("unroll") for (int i = 0; i < NA; ++i) if (i < NA - 2 || i < nch) *(u32x4*)(Lb + aoff0 + i * 64 * 144) = ra[seta][i]; \
    _Pragma("unroll") for (int ni = 0; ni < 4; ++ni) { half4 hv; hv[0] = (f16)rb[setb][0][ni]; hv[1] = (f16)rb[setb][1][ni]; hv[2] = (f16)rb[setb][2][ni]; hv[3] = (f16)rb[setb][3][ni]; \
        *(half4*)(Lb + boff[ni]) = hv; } } while (0)
#define MOE_COMPUTE(buf, s0, s1) do { const char* Lb = smem + (buf) * MOE_BUF; _Pragma("unroll") for (int s = s0; s < s1; ++s) { \
        half8 af[MI], bf[2]; \
        _Pragma("unroll") for (int mi = 0; mi < MI; ++mi) af[mi] = *(const half8*)(Lb + afrag + mi * 32 * 144 + s * 32); \
        _Pragma("unroll") for (int j = 0; j < 2; ++j) bf[j] = *(const half8*)(Lb + bfrag + j * 32 * 144 + s * 32); \
        _Pragma("unroll") for (int mi = 0; mi < MI; ++mi) _Pragma("unroll") for (int j = 0; j < 2; ++j) acc[mi][j] = __builtin_amdgcn_mfma_f32_32x32x16_f16(bf[j], af[mi], acc[mi][j], 0, 0, 0); } } while (0)
#pragma unroll
    for (int t = 0; t < DB; ++t) { MOE_LOADB(t, t); if (t < DA) MOE_LOADA(t, t); }
    MOE_WRITE(0, 0, 0);
    MOE_LOADA(0, DA); MOE_LOADB(0, DB);
    __syncthreads();
#pragma unroll
    for (int kt = 0; kt < NK; ++kt) {
        const int t1 = kt + 1;
        MOE_COMPUTE(kt & 1, 0, 2);
        __builtin_amdgcn_sched_barrier(0);
        if (t1 < NK) {
            MOE_WRITE(t1 % DA, t1 % DB, t1 & 1);
            if (t1 + DA < NK) MOE_LOADA(t1 % DA, t1 + DA);
            if (t1 + DB < NK) MOE_LOADB(t1 % DB, t1 + DB);
        }
        __builtin_amdgcn_sched_barrier(0);
        MOE_COMPUTE(kt & 1, 2, 4);
        __syncthreads();
    }
#undef MOE_LOADA
#undef MOE_LOADB
#undef MOE_WRITE
#undef MOE_COMPUTE
    int av[MI]; float scv[MI];
    {
        int te = tid; asm volatile("" : "+v"(te));
        const int re = te & 31, wme = te >> 7;
#pragma unroll
        for (int mi = 0; mi < MI; ++mi) { const int row = mt * RT + 32 * MI * wme + 32 * mi + re; av[mi] = lst[row < cnt ? row : cnt - 1]; }
#pragma unroll
        for (int mi = 0; mi < MI; ++mi) scv[mi] = IS_GU ? p.rstd2[av[mi] >> 1] : p.gate[av[mi]];
    }
#pragma unroll
    for (int mi = 0; mi < MI; ++mi) {
        const int row = mt * RT + 32 * MI * wm + 32 * mi + r;
        if (row < cnt) {
            const int a = av[mi];
            if (IS_GU) {
                const float rs = scv[mi];
#pragma unroll
                for (int g = 0; g < 4; ++g) {
                    half4 hv;
#pragma unroll
                    for (int e2 = 0; e2 < 4; ++e2) { const float gg = acc[mi][0][4 * g + e2] * rs, uu = acc[mi][1][4 * g + e2] * rs; hv[e2] = (f16)(silu_f(gg) * uu); }
                    *(half4*)(p.Hbuf + (size_t)(rowoff + row) * DE + nt * 64 + 32 * wn + 8 * g + 4 * h) = hv;
                }
            } else {
                const float gt = scv[mi];
#pragma unroll
                for (int j = 0; j < 2; ++j)
#pragma unroll
                    for (int g = 0; g < 4; ++g) {
                        half4 o; o[0] = (f16)(acc[mi][j][4 * g] * gt); o[1] = (f16)(acc[mi][j][4 * g + 1] * gt); o[2] = (f16)(acc[mi][j][4 * g + 2] * gt); o[3] = (f16)(acc[mi][j][4 * g + 3] * gt);
                        *(half4*)(p.Y2 + (size_t)a * D_ + nt * 128 + 64 * wn + 32 * j + 8 * g + 4 * h) = o;
                    }
            }
        }
    }
}

template <bool IS_GU>
__device__ __forceinline__ void phase_moe(const Params& p, char* smem) {
    constexpr int NTN = IS_GU ? 12 : 16;
    int* tab = (int*)(smem + MOE_TAB);
    volatile int* slot = (volatile int*)(smem + MOE_SLOT);
    moe_tables(p, tab);
    const int tid = phase_tid();
    const int own = (int)(xb_xcc_id() & 7u);
    unsigned* ctr0 = p.bar + (IS_GU ? 8192 : 8704);
    for (int lq = 0; lq < 8; ++lq) {
        const int label = (own + lq) & 7;
        unsigned* ctr = ctr0 + 64 * label;
        for (;;) {
            __syncthreads();
            if (tid == 0) *slot = (int)atomicAdd(ctr, 1u);
            __syncthreads();
            const int ticket = *slot;
            int e = -1, local = ticket;
#pragma unroll
            for (int i = 0; i < 8; ++i) {
                const int ee = label + 8 * i, nu = (tab[ee + 1] - tab[ee]) * NTN;
                if (e < 0) { if (local < nu) e = ee; else local -= nu; }
            }
            if (e < 0) break;
            const int mts = tab[e + 1] - tab[e], nt = local / mts, mt = local % mts;
            const int rowoff = tab[65 + e], cnt = tab[66 + e] - rowoff;
            const int* lst = p.list + e * T_;
            int tu = tid; asm volatile("" : "+v"(tu));
            if (cnt <= 256) moe_unit<IS_GU, 2>(p, smem, tu, e, nt, mt, cnt, rowoff, lst);
            else moe_unit<IS_GU, 3>(p, smem, tu, e, nt, mt, cnt, rowoff, lst);
        }
    }
}

__device__ __forceinline__ void phase_final(const Params& p, char* smem) {
    const int tid = phase_tid(), lane = tid & 63, wid = tid >> 6;
    f32x4 gf[8];
#pragma unroll
    for (int i = 0; i < 8; ++i) gf[i] = *(const f32x4*)(p.ln_f + lane * 4 + i * 256);
    for (int t = blockIdx.x * 8 + wid; t < T_; t += gridDim.x * 8) {
        f32x4 v[8]; float ss = 0.f;
#pragma unroll
        for (int i = 0; i < 8; ++i) {
            const int c = lane * 4 + i * 256;
            const f32x4 a = *(const f32x4*)(p.x1 + (size_t)t * D_ + c);
            const half4 b = *(const half4*)(p.Y2 + (size_t)(2 * t) * D_ + c);
            const half4 d = *(const half4*)(p.Y2 + (size_t)(2 * t + 1) * D_ + c);
#pragma unroll
            for (int e = 0; e < 4; ++e) v[i][e] = a[e] + (float)b[e] + (float)d[e];
            ss += v[i][0] * v[i][0] + v[i][1] * v[i][1] + v[i][2] * v[i][2] + v[i][3] * v[i][3];
        }
        ss = wave_sum(ss);
        const float rs = 1.0f / sqrtf(ss * (1.0f / D_) + 1e-6f);
#pragma unroll
        for (int i = 0; i < 8; ++i) {
            const int c = lane * 4 + i * 256;
            const f32x4 g = gf[i];
            f32x4 o; o[0] = v[i][0] * rs * g[0]; o[1] = v[i][1] * rs * g[1]; o[2] = v[i][2] * rs * g[2]; o[3] = v[i][3] * rs * g[3];
            *(f32x4*)(p.out + (size_t)t * D_ + c) = o;
        }
    }
}

extern __shared__ __attribute__((aligned(16))) char dyn_smem[];
__global__ void __launch_bounds__(NTHR, 2) mega(Params p) {
    char* smem = dyn_smem;
    volatile LAS unsigned* xbw = (volatile LAS unsigned*)(dyn_smem + LDS_BYTES - 16);
    if (threadIdx.x == 0) { xbw[0] = 0u; xbw[1] = 0u; xbw[2] = 0u; xbw[3] = 0u; }
    __syncthreads();
    XcdBarrier bar = xcd_barrier_post(p.bar, xbw);
    if (threadIdx.x == 0) xbw[2] = atomicAdd(&p.bar[9472 + 64 * (xb_xcc_id() & 7u)], 1u);
    phase_prologue(p, smem);
    xcd_barrier(bar);
    int cwg = blockIdx.x;
    {
        bool ok = (gridDim.x % 8u) == 0u;
        for (int j = 0; j < 8; ++j) ok = ok && (xb_ld(&p.bar[9472 + 64 * j]) == gridDim.x / 8u);
        if (ok) cwg = (int)((xb_xcc_id() & 7u) + 8u * xbw[2]);
        cwg = __builtin_amdgcn_readfirstlane(cwg);
    }
    phase_inproj(p, smem, cwg);
    {
        const int nun = (T_ / 256) * (NINP / 256), rem = nun % (int)gridDim.x;
        if (rem == 0) phase_deferred(p, smem, cwg, gridDim.x);
        else if (cwg >= rem) phase_deferred(p, smem, cwg - rem, gridDim.x - rem);
    }
    xcd_barrier(bar);
    phase_rwkvprep(p, smem);
    xcd_barrier(bar);
    phase_rwkv1(p, smem);
    xcd_barrier(bar);
    if (blockIdx.x < NH) phase_rwkv2_head(p, smem, blockIdx.x);
    phase_attn(p, smem);
    xcd_barrier(bar);
    phase_rwkv3(p, smem);
    xcd_barrier(bar);
    phase_outproj(p, smem, cwg);
    xcd_barrier(bar);
    phase_router(p, smem);
    xcd_barrier(bar);
    phase_lists(p, smem);
    xcd_barrier(bar);
    phase_moe<true>(p, smem);
    xcd_barrier(bar);
    phase_moe<false>(p, smem);
    xcd_barrier(bar);
    phase_final(p, smem);
}

static inline size_t align_up(size_t v, size_t a) { return (v + a - 1) / a * a; }

extern "C" void kernel_launch(void* const* d_in, const int* in_sizes, int n_in, void* d_out, int out_size, void* d_ws, size_t ws_size, hipStream_t stream) {
    Params p{};
    p.x = (const float*)d_in[0]; p.pos = (const int*)d_in[1]; p.ln1 = (const float*)d_in[2]; p.w_in = (const float*)d_in[3]; p.mu = (const float*)d_in[4];
    p.w_decay0 = (const float*)d_in[5]; p.w_decay_up = (const float*)d_in[6]; p.a0 = (const float*)d_in[7]; p.w_a_up = (const float*)d_in[8]; p.w_g_up = (const float*)d_in[9];
    p.k_k = (const float*)d_in[10]; p.k_a = (const float*)d_in[11]; p.r_k = (const float*)d_in[12]; p.gn_w = (const float*)d_in[13]; p.gn_b = (const float*)d_in[14];
    p.sinks = (const float*)d_in[15]; p.w_out = (const float*)d_in[16]; p.ln2 = (const float*)d_in[17]; p.w_rg = (const float*)d_in[18]; p.b_rg = (const float*)d_in[19];
    p.w_re = (const float*)d_in[20]; p.b_re = (const float*)d_in[21]; p.w_gu = (const float*)d_in[22]; p.w_dn = (const float*)d_in[23]; p.ln_f = (const float*)d_in[24];
    p.out = (float*)d_out;
    char* ws = (char*)d_ws; size_t off = 0;
    auto take = [&](size_t bytes) { char* r = ws + off; off = align_up(off + bytes, 256); return r; };
    p.bar = (unsigned*)take(64 * 1024);
    p.Wr = (float*)take((size_t)D_ * 96 * 4);
    p.WrH = (f16*)take((size_t)96 * D_ * 2); p.WrL = (f16*)take((size_t)96 * D_ * 2);
    p.xh = (f16*)take((size_t)T_ * D_ * 2); p.rstd1 = (float*)take(T_ * 4);
    p.WinT = (f16*)take((size_t)NINP * D_ * 2); p.WoutT = (f16*)take((size_t)D_ * D_ * 2);
    p.WduT = (f16*)take(RW * 64 * 2); p.WauT = (f16*)take(RW * 64 * 2); p.WguT = (f16*)take(RW * 160 * 2);
    p.ropec = (float*)take(T_ * 32 * 4); p.ropes = (float*)take(T_ * 32 * 4);
    p.P = (f16*)take((size_t)T_ * NINP * 2);
    p.qr = (f16*)take((size_t)T_ * 1024 * 2); p.kr = (f16*)take((size_t)T_ * 256 * 2);
    p.Wd = (float*)take((size_t)T_ * RW * 4); p.G = (f16*)take((size_t)T_ * RW * 2);
    p.R = (f16*)take((size_t)T_ * RW * 2); p.K2 = (f16*)take((size_t)T_ * RW * 2); p.V = (f16*)take((size_t)T_ * RW * 2);
    p.A = (f16*)take((size_t)T_ * RW * 2); p.B = (f16*)take((size_t)T_ * RW * 2); p.bonus = (float*)take(T_ * NH * 4);
    p.PT = (f16*)take((size_t)NH * NCHK * 4096 * 2); p.segQ = (f16*)take((size_t)NH * NCHK * 4096 * 2); p.Sst = (f16*)take((size_t)NH * NCHK * 4096 * 2);
    p.ycat = (f16*)take((size_t)T_ * D_ * 2);
    p.x1 = (float*)take((size_t)T_ * D_ * 4); p.xm = (f16*)take((size_t)T_ * D_ * 2); p.rstd2 = (float*)take(T_ * 4);
    p.eid = (int*)take(2 * T_ * 4); p.gate = (float*)take(2 * T_ * 4); p.cnt = (int*)take(NEXP * 4); p.list = (int*)take((size_t)NEXP * T_ * 4);
    p.Hbuf = (f16*)take((size_t)2 * T_ * DE * 2); p.Y2 = (f16*)take((size_t)2 * T_ * D_ * 2); p.Wdn16 = (f16*)take((size_t)NEXP * DE * D_ * 2);

    static int grid = 0;
    if (!grid) {
        int dev = 0, cus = 0, per_cu = 0;
        (void)hipGetDevice(&dev);
        (void)hipDeviceGetAttribute(&cus, hipDeviceAttributeMultiprocessorCount, dev);
        (void)hipFuncSetAttribute((const void*)mega, hipFuncAttributeMaxDynamicSharedMemorySize, LDS_BYTES);
        (void)hipOccupancyMaxActiveBlocksPerMultiprocessor(&per_cu, mega, NTHR, LDS_BYTES);
        if (per_cu < 1) per_cu = 1;
        grid = cus * 1;
        if (grid <= 0) grid = 256;
    }
    (void)hipMemsetAsync(p.bar, 0, 64 * 1024, stream);
    mega<<<dim3(grid), dim3(NTHR), LDS_BYTES, stream>>>(p);
}
```
